# Optimizing an MI355X kernel written in HIP

```python
import jax, jax.numpy as jnp
from jax import lax
import numpy as np

D_MODEL = 1024
BATCH = 16
SEQ = 2048
DEPTH = 4

GRID_W = 64
CTX_LEN = 256
EPS = 1e-6
N_MOD = 6

N_BRANCH = 4
BRANCH_W = 512

N_HEADS = 8
Q_LORA = 256
KV_LORA = 128
NOPE_DIM = 64
ROPE_DIM = 32
V_DIM = BRANCH_W // N_HEADS
QK_DIM = NOPE_DIM + ROPE_DIM
ROPE_HALF = ROPE_DIM // 2
AXIS_PAIRS = ROPE_DIM // 4
ROPE_THETA = 10000.0
Q_BLOCK = 128
ATTN_SCALE = QK_DIM ** -0.5

CONV_W = BRANCH_W
CONV_K = 3

POOL_WINDOWS = (2, 4, 8, 16)
N_POOL_G = len(POOL_WINDOWS)
POOL_GC = BRANCH_W // N_POOL_G
POOL_W = BRANCH_W

SGU_CHUNK = 128
SGU_G = 4
SGU_GC = BRANCH_W // SGU_G
SGU_W = BRANCH_W

KV_OFF = 0
KR_OFF = KV_OFF + KV_LORA
Q_OFF = KR_OFF + ROPE_DIM
CONV_OFF = Q_OFF + Q_LORA
POOL_OFF = CONV_OFF + 3 * CONV_W
SGU_OFF = POOL_OFF + POOL_W
GATE_OFF = SGU_OFF + 2 * SGU_W
N_IN = GATE_OFF + N_BRANCH * D_MODEL

N_EXPERTS = 16
N_EXPERT_GROUPS = 4
EXPERTS_PER_GROUP = N_EXPERTS // N_EXPERT_GROUPS
GROUP_SCORE_TOPK = 2
TOP_K = 2
EXPERT_FF = 256

kernel_name = "hybrid_parallel_mixer_moe_diffusion_trunk"


def rms_norm(x, g):
    xf = x.astype(jnp.float32)
    y = xf * lax.rsqrt(jnp.mean(xf * xf, axis=-1, keepdims=True) + EPS)
    return (y * g.astype(jnp.float32)).astype(x.dtype)


def modulate(xn, shift, scale):
    return xn * (1.0 + scale) + shift


def axial_rope(length):
    rows = length // GRID_W
    grid = jnp.stack(jnp.meshgrid(jnp.arange(rows), jnp.arange(GRID_W), indexing='ij'), -1)
    grid = grid.reshape(rows * GRID_W, 2).astype(jnp.float32)
    inv_freq = ROPE_THETA ** (-jnp.arange(AXIS_PAIRS, dtype=jnp.float32) / AXIS_PAIRS)
    ang = jnp.concatenate([grid[:, :1] * inv_freq, grid[:, 1:] * inv_freq], -1)
    return jnp.cos(ang), jnp.sin(ang)


def apply_rope(t, cos, sin):
    nope, r = t[..., :NOPE_DIM], t[..., NOPE_DIM:]
    r1, r2 = r[..., :ROPE_HALF], r[..., ROPE_HALF:]
    cs = cos[None, :, None, :].astype(t.dtype)
    sn = sin[None, :, None, :].astype(t.dtype)
    return jnp.concatenate([nope, r1 * cs - r2 * sn, r1 * sn + r2 * cs], -1)


def mla_keys_values(p, kv_a_norm_g, w_ukv, k_norm_g, rope):
    ckv = rms_norm(p[..., KV_OFF:KR_OFF], kv_a_norm_g)
    kv = jnp.einsum('blr,rhe->blhe', ckv, w_ukv)
    k_nope, v = kv[..., :NOPE_DIM], kv[..., NOPE_DIM:]
    k_rope = jnp.broadcast_to(p[..., None, KR_OFF:Q_OFF], k_nope.shape[:-1] + (ROPE_DIM,))
    k = rms_norm(jnp.concatenate([k_nope, k_rope], -1), k_norm_g)
    if rope is not None:
        k = apply_rope(k, *rope)
    return k.transpose(0, 2, 1, 3), v.transpose(0, 2, 1, 3)


def mla_queries(p, q_a_norm_g, w_uq, q_norm_g, rope):
    cq = rms_norm(p[..., Q_OFF:CONV_OFF], q_a_norm_g)
    q = rms_norm(jnp.einsum('blr,rhe->blhe', cq, w_uq), q_norm_g)
    if rope is not None:
        q = apply_rope(q, *rope)
    return q.transpose(0, 2, 1, 3)


def block_attention(q, k, v):
    nb_b, n_h, length, _ = q.shape
    nb = length // Q_BLOCK
    qb = jnp.moveaxis(q.reshape(nb_b, n_h, nb, Q_BLOCK, QK_DIM), 2, 0)

    def one_block(qi):
        s = jnp.einsum('bhqd,bhkd->bhqk', qi, k, preferred_element_type=jnp.float32) * ATTN_SCALE
        pr = jax.nn.softmax(s, axis=-1).astype(v.dtype)
        return jnp.einsum('bhqk,bhkd->bhqd', pr, v)

    o = lax.map(one_block, qb)
    return jnp.moveaxis(o, 0, 2).reshape(nb_b, n_h, length, V_DIM)


def short_conv(u, w):
    return lax.conv_general_dilated(
        u, w[:, None, :].astype(u.dtype), window_strides=(1,), padding=((CONV_K // 2, CONV_K // 2),),
        dimension_numbers=('NWC', 'WIO', 'NWC'), feature_group_count=u.shape[-1])


def pool_branch(p, pool_w, pool_scale):
    nb_b, length, _ = p.shape
    pf = p.astype(jnp.float32)
    cs = jnp.pad(jnp.cumsum(pf, axis=1), ((0, 0), (1, 0), (0, 0)))
    t = jnp.arange(length)
    means = []
    for g, w in enumerate(POOL_WINDOWS):
        lo = jnp.clip(t - w // 2, 0, length)
        hi = jnp.clip(t - w // 2 + w, 0, length)
        csg = cs[..., g * POOL_GC:(g + 1) * POOL_GC]
        cnt = (hi - lo).astype(jnp.float32)[None, :, None]
        means.append((csg[:, hi] - csg[:, lo]) / cnt)
    pooled = (jnp.concatenate(means, -1) - pf).astype(p.dtype)
    mixed = jnp.einsum('blgc,gcd->blgd', pooled.reshape(nb_b, length, N_POOL_G, POOL_GC), pool_w)
    return mixed.reshape(nb_b, length, POOL_W) * pool_scale


def sgu_branch(z, sgu_norm_g, sgu_w, sgu_b):
    z = jax.nn.gelu(z)
    u, v = z[..., :SGU_W], z[..., SGU_W:]
    v = rms_norm(v, sgu_norm_g)
    nb_b, length, _ = v.shape
    vc = v.reshape(nb_b, length // SGU_CHUNK, SGU_CHUNK, SGU_G, SGU_GC)
    mixed = jnp.einsum('gpq,bnqgc->bnpgc', sgu_w, vc) + sgu_b.T[None, None, :, :, None]
    return u * mixed.reshape(nb_b, length, SGU_W)


def branch_merge(p, k_all, v_all, rope, q_a_norm_g, w_uq, q_norm_g, conv_w, pool_w, pool_scale,
                 sgu_norm_g, sgu_w, sgu_b, w_branch, w_o):
    nb_b, length, _ = p.shape
    q = mla_queries(p, q_a_norm_g, w_uq, q_norm_g, rope)
    o = block_attention(q, k_all, v_all)
    br_attn = o.transpose(0, 2, 1, 3).reshape(nb_b, length, BRANCH_W)
    gb, gc, u = jnp.split(p[..., CONV_OFF:POOL_OFF], 3, axis=-1)
    br_conv = gb * short_conv(gc * u, conv_w)
    br_pool = pool_branch(p[..., POOL_OFF:SGU_OFF], pool_w, pool_scale)
    br_sgu = sgu_branch(p[..., SGU_OFF:GATE_OFF], sgu_norm_g, sgu_w, sgu_b)
    gates = jax.nn.sigmoid(p[..., GATE_OFF:].reshape(nb_b, length, N_BRANCH, D_MODEL))
    br = jnp.stack([br_attn, br_conv, br_pool, br_sgu], axis=2)
    merged = jnp.sum(gates * jnp.einsum('blnc,ncd->blnd', br, w_branch), axis=2)
    return merged @ w_o


def grouped_moe(h, router_w, router_b, w1, w3, w2):
    logits = jnp.einsum('bld,de->ble', h, router_w, preferred_element_type=jnp.float32)
    s = jax.nn.sigmoid(logits)
    sb = s + router_b.astype(jnp.float32)
    grp = sb.reshape(sb.shape[:-1] + (N_EXPERT_GROUPS, EXPERTS_PER_GROUP))
    gscore = jnp.sum(lax.top_k(grp, GROUP_SCORE_TOPK)[0], axis=-1)
    gsel = jnp.argmax(gscore, axis=-1)
    in_group = (jnp.arange(N_EXPERTS) // EXPERTS_PER_GROUP) == gsel[..., None]
    _, idx = lax.top_k(jnp.where(in_group, sb, -jnp.inf), TOP_K)
    w = jnp.take_along_axis(s, idx, axis=-1)
    w = w / jnp.sum(w, axis=-1, keepdims=True)
    combine = jnp.sum(jax.nn.one_hot(idx, N_EXPERTS, dtype=jnp.float32) * w[..., None], axis=-2)
    combine = combine.astype(h.dtype)
    y = jnp.zeros_like(h)
    for e in range(N_EXPERTS):
        a = jax.nn.silu(h @ w1[e]) * (h @ w3[e])
        y = y + combine[..., e:e + 1] * (a @ w2[e])
    return y


def setup_inputs(seed: int = 0) -> dict:
    key = jax.random.key(seed)
    ks = iter(jax.random.split(key, 32))
    f32 = jnp.float32

    def nrm(shape, scale):
        return jax.random.normal(next(ks), shape, f32) * scale

    def gain(shape):
        return 1.0 + nrm(shape, 0.05)

    return {
        "x": nrm((BATCH, SEQ, D_MODEL), 1.0),
        "c": nrm((BATCH, D_MODEL), 1.0),
        "ctx": nrm((BATCH, CTX_LEN, D_MODEL), 1.0),
        "c_ctx": nrm((D_MODEL,), 1.0),
        "mod_w": nrm((DEPTH, D_MODEL, N_MOD * D_MODEL), 0.5 * D_MODEL ** -0.5),
        "mod_b": nrm((DEPTH, N_MOD * D_MODEL), 0.01),
        "norm1_g": gain((DEPTH, D_MODEL)),
        "norm2_g": gain((DEPTH, D_MODEL)),
        "w_in": nrm((DEPTH, D_MODEL, N_IN), D_MODEL ** -0.5),
        "kv_a_norm_g": gain((DEPTH, KV_LORA)),
        "w_ukv": nrm((DEPTH, KV_LORA, N_HEADS, NOPE_DIM + V_DIM), KV_LORA ** -0.5),
        "k_norm_g": gain((DEPTH, QK_DIM)),
        "q_a_norm_g": gain((DEPTH, Q_LORA)),
        "w_uq": nrm((DEPTH, Q_LORA, N_HEADS, QK_DIM), Q_LORA ** -0.5),
        "q_norm_g": gain((DEPTH, QK_DIM)),
        "conv_w": nrm((DEPTH, CONV_K, CONV_W), CONV_K ** -0.5),
        "pool_w": nrm((DEPTH, N_POOL_G, POOL_GC, POOL_GC), POOL_GC ** -0.5),
        "pool_scale": gain((DEPTH, POOL_W)),
        "sgu_norm_g": gain((DEPTH, SGU_W)),
        "sgu_w": nrm((DEPTH, SGU_G, SGU_CHUNK, SGU_CHUNK), SGU_CHUNK ** -0.5),
        "sgu_b": gain((DEPTH, SGU_G, SGU_CHUNK)),
        "w_branch": nrm((DEPTH, N_BRANCH, BRANCH_W, D_MODEL), BRANCH_W ** -0.5),
        "w_o": nrm((DEPTH, D_MODEL, D_MODEL), D_MODEL ** -0.5),
        "router_w": nrm((D_MODEL, N_EXPERTS), D_MODEL ** -0.5),
        "router_b": nrm((N_EXPERTS,), 0.01),
        "moe_w1": nrm((DEPTH, N_EXPERTS, D_MODEL, EXPERT_FF), D_MODEL ** -0.5),
        "moe_w3": nrm((DEPTH, N_EXPERTS, D_MODEL, EXPERT_FF), D_MODEL ** -0.5),
        "moe_w2": nrm((DEPTH, N_EXPERTS, EXPERT_FF, D_MODEL), EXPERT_FF ** -0.5),
    }


def reference(x, c, ctx, c_ctx, mod_w, mod_b, norm1_g, norm2_g, w_in, kv_a_norm_g, w_ukv, k_norm_g,
              q_a_norm_g, w_uq, q_norm_g, conv_w, pool_w, pool_scale, sgu_norm_g, sgu_w, sgu_b,
              w_branch, w_o, router_w, router_b, moe_w1, moe_w3, moe_w2):
    nb_b, length, d = x.shape
    rope = axial_rope(length)
    sc = jax.nn.silu(c)
    scc = jax.nn.silu(c_ctx)
    xc = ctx
    for i in range(DEPTH):
        update_ctx = i < DEPTH - 1
        m = (sc @ mod_w[i] + mod_b[i]).reshape(nb_b, N_MOD, 1, d)
        mc = (scc @ mod_w[i] + mod_b[i]).reshape(N_MOD, d)
        h = modulate(rms_norm(x, norm1_g[i]), m[:, 0], m[:, 1])
        hc = modulate(rms_norm(xc, norm1_g[i]), mc[0], mc[1])
        p = h @ w_in[i]
        pc = hc @ (w_in[i] if update_ctx else w_in[i][:, :Q_OFF])
        k_c, v_c = mla_keys_values(pc, kv_a_norm_g[i], w_ukv[i], k_norm_g[i], None)
        k_l, v_l = mla_keys_values(p, kv_a_norm_g[i], w_ukv[i], k_norm_g[i], rope)
        k_all = jnp.concatenate([k_c, k_l], axis=2)
        v_all = jnp.concatenate([v_c, v_l], axis=2)
        mix = branch_merge(p, k_all, v_all, rope, q_a_norm_g[i], w_uq[i], q_norm_g[i], conv_w[i],
                           pool_w[i], pool_scale[i], sgu_norm_g[i], sgu_w[i], sgu_b[i],
                           w_branch[i], w_o[i])
        x = x + m[:, 2] * mix
        h2 = modulate(rms_norm(x, norm2_g[i]), m[:, 3], m[:, 4])
        x = x + m[:, 5] * grouped_moe(h2, router_w, router_b, moe_w1[i], moe_w3[i], moe_w2[i])
        if update_ctx:
            mix_c = branch_merge(pc, k_c, v_c, None, q_a_norm_g[i], w_uq[i], q_norm_g[i], conv_w[i],
                                 pool_w[i], pool_scale[i], sgu_norm_g[i], sgu_w[i], sgu_b[i],
                                 w_branch[i], w_o[i])
            xc = xc + mc[2] * mix_c
            hc2 = modulate(rms_norm(xc, norm2_g[i]), mc[3], mc[4])
            xc = xc + mc[5] * grouped_moe(hc2, router_w, router_b, moe_w1[i], moe_w3[i], moe_w2[i])
    return x
```

```cpp
#include <hip/hip_runtime.h>
#include <stdint.h>
#include <stdio.h>

#define LAS __attribute__((address_space(3)))
typedef unsigned short bf16_t;
typedef short bf16x8 __attribute__((ext_vector_type(8)));
typedef short s16x4 __attribute__((ext_vector_type(4)));
typedef float f32x2 __attribute__((ext_vector_type(2)));
typedef float f32x4 __attribute__((ext_vector_type(4)));
typedef float f32x16 __attribute__((ext_vector_type(16)));
typedef unsigned u32x2 __attribute__((ext_vector_type(2)));
typedef unsigned u32x4 __attribute__((ext_vector_type(4)));
typedef __bf16 bf16v2 __attribute__((ext_vector_type(2)));

constexpr int DM = 1024, NB = 16, LAT = 2048, CTX = 256, TPB = 2304, NTOK = NB * TPB, DEPTH = 4;
constexpr int NPAN = NTOK / 256;
constexpr int HROWS = NTOK / 2, HPAN = NPAN / 2;
constexpr int N_IN = 7584, Q_OFF = 160, CONV_OFF = 416, POOL_OFF = 1952, SGU_OFF = 2464, GATE_OFF = 3488;
constexpr int PLD = 3584;
constexpr int NH = 8, QKD = 96, VD = 64;
constexpr float EPS = 1e-6f;
constexpr float QSCALE = 0.10206207261596575f * 1.4426950408889634f;
constexpr int NMOD = 6, MODLD = 17 * NMOD * DM;
constexpr int MAXT = 168;

enum { I_X = 0, I_C, I_CTX, I_CCTX, I_MODW, I_MODB, I_N1G, I_N2G, I_WIN, I_KVG, I_WUKV, I_KNG, I_QAG, I_WUQ, I_QNG, I_CONVW, I_POOLW, I_POOLS, I_SGUNG, I_SGUW, I_SGUB,
       I_WBR, I_WO, I_RW, I_RB, I_W1, I_W3, I_W2, N_INPUTS };

constexpr size_t WS_BAR = 0;
constexpr size_t WS_MOD = 65536;
constexpr size_t WS_ROPE = WS_MOD + 1671168;
constexpr size_t WS_XC = WS_ROPE + 262144;
constexpr size_t WS_H = WS_XC + 16777216;
constexpr size_t WS_W = WS_H + 75497472;
constexpr size_t W_IN = 0, W_G = W_IN + 7340032, W_UQ = W_G + 8388608, W_UKV = W_UQ + 393216, W_B = W_UKV + 524288, W_O = W_B + 4194304,
                 W_13 = W_O + 2097152, W_2 = W_13 + 16777216, W_SGU = W_2 + 8388608, W_END = W_SGU + 131072;
constexpr size_t WS_BR = WS_W + W_END;
constexpr size_t WS_MIX = WS_BR + 150994944;
constexpr size_t MIX_P = 0, MIX_QRAW = MIX_P + 132120576, MIX_KVRAW = MIX_QRAW + 28311552, MIX_Q = MIX_KVRAW + 37748736, MIX_K = MIX_Q + 28311552,
                 MIX_V = MIX_K + 37748736, MIX_END = MIX_V + 18874368;
constexpr size_t MIX_S8 = 0, MIX_MERGED = 150994944;
constexpr size_t MIX_OUT = 0;
constexpr size_t MOE_CLS = 226492416, MOE_WTS = MOE_CLS + 147456, MOE_BLK = MOE_WTS + 294912, MOE_TILE = MOE_BLK + 32768, MOE_SIDX = MOE_TILE + 4096,
                 MOE_SW = MOE_SIDX + 172032, MOE_ACT = MOE_SW + 344064;
constexpr size_t WS_H8 = WS_MIX + MIX_END;
constexpr size_t WS_SS = WS_H8 + 37748736;
constexpr size_t WS_END = WS_SS + (size_t)HROWS * 32;
static_assert(MIX_MERGED + 75497472 <= MOE_CLS && MOE_ACT + 44040192 <= MIX_END && MOE_CLS + 33554432 <= MIX_END, "alias map");

constexpr int LDS_BYTES = 147456;
constexpr int LDS_MISC = 131072;

__device__ __forceinline__ unsigned pk2(float lo, float hi) { f32x2 v = {lo, hi}; bf16v2 b = __builtin_convertvector(v, bf16v2); return __builtin_bit_cast(unsigned, b); }
__device__ __forceinline__ float bflo(unsigned u) { return __uint_as_float(u << 16); }
__device__ __forceinline__ float bfhi(unsigned u) { return __uint_as_float(u & 0xffff0000u); }
__device__ __forceinline__ float bf2f(bf16_t b) { return __uint_as_float(((unsigned)b) << 16); }
__device__ __forceinline__ float fast_sigmoid(float x) { return __builtin_amdgcn_rcpf(1.0f + __builtin_amdgcn_exp2f(-1.4426950408889634f * x)); }
__device__ __forceinline__ float gelu_tanh(float x) { const float u = 0.7978845608028654f * (x + 0.044715f * x * x * x); return x * fast_sigmoid(2.0f * u); }
__device__ __forceinline__ f32x4 gelu_tanh4(f32x4 x) {
    const f32x4 k1 = {-2.302208198144325f, -2.302208198144325f, -2.302208198144325f, -2.302208198144325f}, k3 = {-0.1029432395800235f, -0.1029432395800235f, -0.1029432395800235f, -0.1029432395800235f}, one = {1.f, 1.f, 1.f, 1.f};
    const f32x4 z = x * (x * x * k3 + k1); f32x4 e;
#pragma unroll
    for (int j = 0; j < 4; ++j) e[j] = __builtin_amdgcn_exp2f(z[j]);
    const f32x4 d = e + one; f32x4 r;
#pragma unroll
    for (int j = 0; j < 4; ++j) r[j] = __builtin_amdgcn_rcpf(d[j]);
    return x * r;
}
__device__ __forceinline__ unsigned pk4_fp8(float a, float b, float c, float d) { int w = __builtin_amdgcn_cvt_pk_fp8_f32(a, b, 0, false); w = __builtin_amdgcn_cvt_pk_fp8_f32(c, d, w, true); return (unsigned)w; }
__device__ __forceinline__ void st16_wt(void* p, u32x4 w) { asm volatile("global_store_dwordx4 %0, %1, off sc1\n\ts_nop 1" :: "v"((unsigned long long)p), "v"(w) : "memory"); }
__device__ __forceinline__ int ld_agent(const int* p) { return __hip_atomic_load(p, __ATOMIC_RELAXED, __HIP_MEMORY_SCOPE_AGENT); }
__device__ __forceinline__ float shx(float v, int m, int lane) { return __int_as_float(__builtin_amdgcn_ds_bpermute((lane ^ m) << 2, __float_as_int(v))); }
__device__ __forceinline__ int shxi(int v, int m, int lane) { return __builtin_amdgcn_ds_bpermute((lane ^ m) << 2, v); }
__device__ __forceinline__ float wave_sum(float v, int lane) {
#pragma unroll
    for (int o = 32; o >= 1; o >>= 1) v += shx(v, o, lane);
    return v; }
__device__ __forceinline__ void unpack8(const u32x4 w, float (&f)[8]) { f[0] = bflo(w.x); f[1] = bfhi(w.x); f[2] = bflo(w.y); f[3] = bfhi(w.y); f[4] = bflo(w.z); f[5] = bfhi(w.z); f[6] = bflo(w.w); f[7] = bfhi(w.w); }

#define XB_TMO      128
#define XB_XCNT(j)  (256  + 64 * (j))
#define XB_XSUB(j)  (1280 + 64 * (j))
#define XB_XGEN(j)  (2304 + 64 * (j))
#define XB_TOP      3328
#define XB_TOPGEN   3392
#define XCD_BAR_WORDS 3456
#define XB_SPIN_CAP (1u << 22)
__device__ __forceinline__ unsigned xb_ld(unsigned* p)              { return __hip_atomic_load(p, __ATOMIC_RELAXED, __HIP_MEMORY_SCOPE_AGENT); }
__device__ __forceinline__ unsigned xb_add(unsigned* p, unsigned v) { return __hip_atomic_fetch_add(p, v, __ATOMIC_RELAXED, __HIP_MEMORY_SCOPE_AGENT); }
__device__ __forceinline__ unsigned xb_xcc_id() { return (unsigned)__builtin_amdgcn_s_getreg((3 << 11) | 20) & 0xFu; }
#define XB_SPIN(cond, bar) do { unsigned _sp = 0; while (cond) { __builtin_amdgcn_s_sleep(1); \
    if ((++_sp & 255u) == 0u) { if (xb_ld(&(bar)[XB_TMO])) break; if (_sp > XB_SPIN_CAP) { atomicAdd(&(bar)[XB_TMO], 1u); break; } } } } while (0)
struct XcdBarrier { unsigned* bar; unsigned x; volatile LAS unsigned* st; };
__device__ __forceinline__ XcdBarrier xcd_barrier_post(unsigned* bar, volatile LAS unsigned* st) {
    XcdBarrier b; b.bar = bar; b.x = xb_xcc_id(); b.st = st;
    if (threadIdx.x == 0) (void)xb_add(&bar[XB_XCNT(b.x)], 1u);
    return b;
}
__device__ __forceinline__ void xcd_barrier_complete(unsigned* bar, unsigned x, unsigned& nloc, unsigned& nx) {
    const unsigned G = gridDim.x * gridDim.y * gridDim.z;
    unsigned sum, cnt, mine, sp = 0u;
    for (;;) {
        sum = 0u; cnt = 0u; mine = 0u;
#pragma unroll
        for (unsigned j = 0; j < 16; ++j) { const unsigned c = xb_ld(&bar[XB_XCNT(j)]); sum += c; cnt += (c > 0u) ? 1u : 0u; mine = (j == x) ? c : mine; }
        if (sum == G) break;
        __builtin_amdgcn_s_sleep(1);
        if ((++sp & 255u) == 0u) { if (xb_ld(&bar[XB_TMO])) break; if (sp > XB_SPIN_CAP) { atomicAdd(&bar[XB_TMO], 1u); break; } }
    }
    nloc = mine > 0u ? mine : 1u; nx = cnt > 0u ? cnt : 1u;
}
__device__ __forceinline__ void xcd_barrier(const XcdBarrier& b) {
    asm volatile("s_waitcnt vmcnt(0)" ::: "memory");
    __syncthreads();
    if (threadIdx.x == 0) {
        unsigned* bar = b.bar;
        __builtin_amdgcn_s_waitcnt(0);
        unsigned nloc = b.st[0], nx = b.st[1];
        if (nloc == 0u) { xcd_barrier_complete(bar, b.x, nloc, nx); b.st[0] = nloc; b.st[1] = nx; }
        const unsigned old = xb_add(&bar[XB_XSUB(b.x)], 1u);
        const unsigned gen = old / nloc;
        if (old + 1u == (gen + 1u) * nloc) {
            __builtin_amdgcn_fence(__ATOMIC_RELEASE, "agent");
            asm volatile("s_waitcnt vmcnt(0)" ::: "memory");
            const unsigned og = xb_add(&bar[XB_TOP], 1u);
            const unsigned tg = og / nx;
            if (og + 1u == (tg + 1u) * nx) xb_add(&bar[XB_TOPGEN], 1u);
            else XB_SPIN(xb_ld(&bar[XB_TOPGEN]) == tg, bar);
            __builtin_amdgcn_fence(__ATOMIC_ACQUIRE, "agent");
            xb_add(&bar[XB_XGEN(b.x)], 1u);
            asm volatile("s_waitcnt vmcnt(0)" ::: "memory");
        } else {
            XB_SPIN(xb_ld(&bar[XB_XGEN(b.x)]) == gen, bar);
            __builtin_amdgcn_fence(__ATOMIC_ACQUIRE, "agent");
            asm volatile("s_waitcnt vmcnt(0)" ::: "memory");
        }
    }
    __syncthreads();
}

namespace pg {
constexpr int BM = 256, BK = 64, HALF = 128, HTB = HALF * BK * 2, STAGE_BYTES = 8 * HTB, NXCD = 8, WGM = 8;
__device__ __forceinline__ int lds_byte(int r, int c) { const int st = (r >> 4) * 2 + (c >> 5), rr = r & 15, cc = c & 31, ob = rr * 64 + cc * 2; return st * 1024 + (ob ^ (((ob >> 9) & 1) << 5)); }
__device__ __forceinline__ void stage_rc(int b, int& R, int& C) { const int st = b / 1024, sb = b % 1024, swz = sb ^ (((sb >> 9) & 1) << 5); R = (st >> 1) * 16 + swz / 64; C = (st & 1) * 32 + (swz % 64) / 2; }
__device__ __forceinline__ int perm32(int rho) { const int n = rho >> 4, i = rho & 15; return 8 * (i >> 2) + 4 * n + (i & 3); }
struct Unit { int pm, pn, aux; };

__device__ __forceinline__ bool grid_tile(long L, int nM, int nN, int& pm, int& pn) {
    const int nwg = nM * nN; if (L >= nwg) return false;
    int wgid = (int)L; { const int q = nwg / NXCD, r = nwg % NXCD, xcd = wgid % NXCD, off = wgid / NXCD; wgid = (xcd < r ? xcd * (q + 1) : r * (q + 1) + (xcd - r) * q) + off; }
    const int nig = WGM * nN, gid = wgid / nig, fm = gid * WGM, gsz = (nM - fm) < WGM ? (nM - fm) : WGM;
    pm = fm + ((wgid % nig) % gsz); pn = (wgid % nig) / gsz; return true;
}
struct SchedGrid {
    static constexpr bool GATHER = false, FP8 = false;
    const char* A; const char* B; unsigned lda_, ldb_; int nt_, nM, nN, G, c, latent_only;
    __device__ __forceinline__ void init(const void* A_, unsigned lda__, const void* B_, unsigned ldb__, int K, int nM_, int nN_, int lat = 0) { A = (const char*)A_; B = (const char*)B_; lda_ = lda__; ldb_ = ldb__; nt_ = K / BK; nM = nM_; nN = nN_; G = gridDim.x; c = blockIdx.x; latent_only = lat; }
    __device__ __forceinline__ bool next(int i, Unit& u) const { u.aux = 0; const bool ok = grid_tile((long)i * G + c, nM, nN, u.pm, u.pn); if (latent_only) u.pm = (u.pm >> 3) * 9 + 1 + (u.pm & 7); return ok; }
    __device__ __forceinline__ void setup(const Unit& u, const char*& a, const char*& b0, const char*& b1, unsigned& lda, unsigned& ldb, int& nt, int& nt0) const { a = A + (size_t)u.pm * 256 * lda_; b0 = B + (size_t)u.pn * 256 * ldb_; b1 = b0; lda = lda_; ldb = ldb_; nt = nt_; nt0 = nt_; }
    __device__ __forceinline__ unsigned rowoff(const Unit&, int) const { return 0u; }
    __device__ __forceinline__ bool keep_acc(const Unit&) const { return false; }
};

struct SchedGrid8 : SchedGrid { static constexpr bool FP8 = true; };
typedef int v8i32 __attribute__((ext_vector_type(8)));
typedef int v4i32 __attribute__((ext_vector_type(4)));
constexpr int MX_SCALE_ONE = 0x7f7f7f7f, MX_SCALE_W = 0x7a7a7a7a;
__device__ __forceinline__ int lds_byte8(int r, int fq) { const int rr = r & 15; return ((r >> 4) * 2 + (fq >> 1)) * 1024 + ((rr * 64 + (fq & 1) * 32) ^ ((rr >> 3) << 5)); }

template <class E, class = void> struct Perm16 { static constexpr bool v = false; };
template <class E> struct Perm16<E, decltype((void)E::PERM16)> { static constexpr bool v = E::PERM16; };
template <class E, class = void> struct AccInit { static constexpr float v = 0.f; };
template <class E> struct AccInit<E, decltype((void)E::ACC0)> { static constexpr float v = E::ACC0; };
template <class Epi, class Sched>
__device__ __forceinline__ void gemm_phase(LAS unsigned char* lds, const Sched& S, const Epi& E) {
    constexpr bool GATHER = Sched::GATHER, FP8 = Sched::FP8; constexpr int KOFF = FP8 ? 16 : 1024;
    int tid = threadIdx.x; asm volatile("" : "+v"(tid));
    const int wid = __builtin_amdgcn_readfirstlane(tid >> 6), lane = tid & 63, wr = wid >> 2, wc = wid & 3, fr = lane & 15, fq = lane >> 4;
    unsigned Rp0, C20, Rbp0; { int R, C; stage_rc(tid * 16, R, C); Rp0 = (unsigned)R; C20 = (unsigned)C * 2u; Rbp0 = (unsigned)(Perm16<Epi>::v ? (64 * (R >> 5) + 16 * ((R & 15) >> 2) + 4 * ((R >> 4) & 1) + (R & 3)) : (Epi::PERM ? ((R & ~31) + perm32(R & 31)) : R)); }
    const unsigned ldsw = (unsigned)wid * 1024u;
    const unsigned foff = (unsigned)(FP8 ? lds_byte8(fr, fq) : lds_byte(fr, fq * 8)); const unsigned sa = (unsigned)wr * 8192u, sb = (unsigned)wc * 4096u;
#define PG_SA(b, h) (((b) * 2 + (h)) * HTB)
#define PG_SB(b, h) ((4 + (b) * 2 + (h)) * HTB)
#define PG_GLDS(gptr, bufoff, i) __builtin_amdgcn_global_load_lds((const unsigned*)(gptr), (LAS unsigned*)(lds + (bufoff) + ldsw + (i) * 8192), 16, 0, 0)
#define PG_STAGE_A(bufoff, base, h, ldx, garr) do { const char* _sb = GATHER ? (base) : (base) + (size_t)(h) * 128u * (ldx); _Pragma("unroll") for (int _i = 0; _i < 2; ++_i) { \
        unsigned _r = Rp0; asm volatile("" : "+v"(_r)); const unsigned _vo = GATHER ? garr[h][_i] + C20 : _r * (ldx) + C20; PG_GLDS(_sb + (GATHER ? (size_t)0 : (size_t)_i * 64u * (ldx)) + _vo, bufoff, _i); } } while (0)
#define PG_STAGE_B(bufoff, base, h, ldx) do { const char* _sb = (base) + (size_t)(h) * (Perm16<Epi>::v ? 8u : 128u) * (ldx); _Pragma("unroll") for (int _i = 0; _i < 2; ++_i) { \
        unsigned _r = Rbp0; asm volatile("" : "+v"(_r)); const unsigned _vo = _r * (ldx) + C20; PG_GLDS(_sb + (size_t)_i * (Perm16<Epi>::v ? 128u : 64u) * (ldx) + _vo, bufoff, _i); } } while (0)
#define PG_LDA(dst, b, h) do { unsigned aoff = foff + sa; asm volatile("" : "+v"(aoff)); _Pragma("unroll") for (int m = 0; m < 4; ++m) _Pragma("unroll") for (int k = 0; k < 2; ++k) dst[m][k] = *(const LAS bf16x8*)(lds + PG_SA(b, h) + aoff + m * 2048 + k * KOFF); } while (0)
#define PG_LDB(dst, b, h) do { unsigned boff = foff + sb; asm volatile("" : "+v"(boff)); _Pragma("unroll") for (int n = 0; n < 2; ++n) _Pragma("unroll") for (int k = 0; k < 2; ++k) dst[n][k] = *(const LAS bf16x8*)(lds + PG_SB(b, h) + boff + n * 2048 + k * KOFF); } while (0)
#define PG_CAT8(x) __builtin_shufflevector(__builtin_bit_cast(v4i32, (x)[0]), __builtin_bit_cast(v4i32, (x)[1]), 0, 1, 2, 3, 4, 5, 6, 7)
#define PG_MMA(ai, bj, At, Bt) do { __builtin_amdgcn_s_setprio(1); if constexpr (FP8) { _Pragma("unroll") for (int m = 0; m < 4; ++m) _Pragma("unroll") for (int n = 0; n < 2; ++n) \
            acc[ai][bj][m][n] = __builtin_amdgcn_mfma_scale_f32_16x16x128_f8f6f4(PG_CAT8(Bt[n]), PG_CAT8(At[m]), acc[ai][bj][m][n], 0, 0, 0, MX_SCALE_W, 0, MX_SCALE_ONE); } \
        else { _Pragma("unroll") for (int m = 0; m < 4; ++m) _Pragma("unroll") for (int n = 0; n < 2; ++n) _Pragma("unroll") for (int k = 0; k < 2; ++k) \
            acc[ai][bj][m][n] = __builtin_amdgcn_mfma_f32_16x16x32_bf16(Bt[n][k], At[m][k], acc[ai][bj][m][n], 0, 0, 0); } __builtin_amdgcn_s_setprio(0); } while (0)
#define PG_WAIT_V(n) asm volatile("s_waitcnt vmcnt(" #n ")" ::: "memory")
#define PG_WAIT_L(n) asm volatile("s_waitcnt lgkmcnt(" #n ")" ::: "memory")
#define PG_BAR __builtin_amdgcn_s_barrier()
#define PG_SCHED __builtin_amdgcn_sched_barrier(0)
#define PG_BSEL(b0, b1, t, n0) ((t) < (n0) ? (b0) + (size_t)(t) * 128 : (b1) + (size_t)((t) - (n0)) * 128)
    Unit cur, nxt; int ui = 0;
    if (!S.next(0, cur)) return;
    f32x4 acc[2][2][4][2];
    float zacc = AccInit<Epi>::v; asm volatile("" : "+v"(zacc));
#pragma unroll
    for (int a = 0; a < 2; ++a)
#pragma unroll
        for (int b = 0; b < 2; ++b)
#pragma unroll
            for (int m = 0; m < 4; ++m)
#pragma unroll
                for (int n = 0; n < 2; ++n) acc[a][b][m][n] = (f32x4){zacc, zacc, zacc, zacc};
    bf16x8 At[4][2], B0[2][2], B1[2][2];
    const char *cA, *cB0, *cB1; int nt, nt0; unsigned lda, ldb; unsigned gA[2][2], ngA[2][2];
    S.setup(cur, cA, cB0, cB1, lda, ldb, nt, nt0);
#pragma unroll
    for (int h = 0; h < 2; ++h)
#pragma unroll
        for (int i = 0; i < 2; ++i) { gA[h][i] = GATHER ? S.rowoff(cur, h * HALF + (int)Rp0 + 64 * i) : 0u; ngA[h][i] = gA[h][i]; }
    { const char* b0p = PG_BSEL(cB0, cB1, 0, nt0); const char* b1p = PG_BSEL(cB0, cB1, 1, nt0);
      PG_STAGE_B(PG_SB(0, 0), b0p, 0, ldb); PG_STAGE_A(PG_SA(0, 0), cA, 0, lda, gA); PG_STAGE_B(PG_SB(0, 1), b0p, 1, ldb); PG_STAGE_A(PG_SA(0, 1), cA, 1, lda, gA);
      if (wr == 1) PG_BAR;
      PG_WAIT_V(4); PG_BAR;
      PG_STAGE_B(PG_SB(1, 0), b1p, 0, ldb); PG_STAGE_A(PG_SA(1, 0), cA + 128, 0, lda, gA); PG_STAGE_B(PG_SB(1, 1), b1p, 1, ldb);
      PG_WAIT_V(6); PG_BAR; }
    for (;;) {
        const bool has_next = S.next(ui + 1, nxt);
        const char *nA = cA, *nB0 = cB0, *nB1 = cB1; int nnt = nt, nnt0 = nt0; unsigned nlda = lda, nldb = ldb;
        if (has_next) S.setup(nxt, nA, nB0, nB1, nlda, nldb, nnt, nnt0);
        for (int t = 0; t < nt; t += 2) {
            const bool last = (t == nt - 2);
            if constexpr (GATHER) {
                if (last && has_next) {
#pragma unroll
                    for (int h = 0; h < 2; ++h)
#pragma unroll
                        for (int i = 0; i < 2; ++i) ngA[h][i] = S.rowoff(nxt, h * HALF + (int)Rp0 + 64 * i);
                }
            }
            const char* a1 = cA + (size_t)(t + 1) * 128;
            const char* a2 = last ? nA : cA + (size_t)(t + 2) * 128; const char* a3 = a2 + 128;
            const char* b2 = last ? PG_BSEL(nB0, nB1, 0, nnt0) : PG_BSEL(cB0, cB1, t + 2, nt0);
            const char* b3 = last ? PG_BSEL(nB0, nB1, 1, nnt0) : PG_BSEL(cB0, cB1, t + 3, nt0);
            const unsigned xlda = last ? nlda : lda, xldb = last ? nldb : ldb;
            unsigned wA[2][2]; const unsigned lmask = (GATHER && last) ? 0xffffffffu : 0u;
#pragma unroll
            for (int h = 0; h < 2; ++h)
#pragma unroll
                for (int i = 0; i < 2; ++i) wA[h][i] = gA[h][i] ^ ((gA[h][i] ^ ngA[h][i]) & lmask);
            PG_LDB(B0, 0, 0); PG_SCHED; PG_LDA(At, 0, 0); PG_STAGE_A(PG_SA(1, 1), a1, 1, lda, gA);
            PG_WAIT_L(8); PG_BAR; PG_WAIT_L(0); PG_MMA(0, 0, At, B0); PG_BAR; PG_SCHED;
            PG_LDB(B1, 0, 1); PG_STAGE_B(PG_SB(0, 0), b2, 0, xldb);
            PG_BAR; PG_WAIT_L(0); PG_MMA(0, 1, At, B1); PG_BAR;
            PG_LDA(At, 0, 1); PG_STAGE_A(PG_SA(0, 0), a2, 0, xlda, wA);
            PG_BAR; PG_WAIT_L(0); PG_MMA(1, 0, At, B0); PG_BAR; PG_SCHED;
            PG_STAGE_B(PG_SB(0, 1), b2, 1, xldb);
            PG_WAIT_V(6); PG_BAR; PG_MMA(1, 1, At, B1); PG_BAR;
            PG_LDB(B0, 1, 0); PG_SCHED; PG_LDA(At, 1, 0); PG_STAGE_A(PG_SA(0, 1), a2, 1, xlda, wA);
            PG_WAIT_L(8); PG_BAR; PG_WAIT_L(0); PG_MMA(0, 0, At, B0); PG_BAR; PG_SCHED;
            PG_LDB(B1, 1, 1); PG_STAGE_B(PG_SB(1, 0), b3, 0, xldb);
            PG_BAR; PG_WAIT_L(0); PG_MMA(0, 1, At, B1); PG_BAR;
            PG_LDA(At, 1, 1); PG_STAGE_A(PG_SA(1, 0), a3, 0, xlda, wA);
            PG_BAR; PG_WAIT_L(0); PG_MMA(1, 0, At, B0); PG_BAR; PG_SCHED;
            PG_STAGE_B(PG_SB(1, 1), b3, 1, xldb);
            PG_WAIT_V(6); PG_BAR; PG_MMA(1, 1, At, B1); PG_BAR;
        }
        PG_SCHED; { int t2 = threadIdx.x; asm volatile("" : "+v"(t2)); E(acc, cur, wr, wc, t2 & 15, (t2 >> 4) & 3); } PG_SCHED;
        if (!has_next) break;
        if (!S.keep_acc(nxt)) {
            float z2 = AccInit<Epi>::v; asm volatile("" : "+v"(z2));
#pragma unroll
            for (int a = 0; a < 2; ++a)
#pragma unroll
                for (int b = 0; b < 2; ++b)
#pragma unroll
                    for (int m = 0; m < 4; ++m)
#pragma unroll
                        for (int n = 0; n < 2; ++n) acc[a][b][m][n] = (f32x4){z2, z2, z2, z2};
        }
        cur = nxt; cA = nA; cB0 = nB0; cB1 = nB1; nt = nnt; nt0 = nnt0; lda = nlda; ldb = nldb; ++ui;
#pragma unroll
        for (int h = 0; h < 2; ++h)
#pragma unroll
            for (int i = 0; i < 2; ++i) gA[h][i] = ngA[h][i];
    }
    PG_WAIT_V(0);
    if (wr == 0) PG_BAR;
    PG_BAR;
#undef PG_SA
#undef PG_SB
#undef PG_GLDS
#undef PG_STAGE_A
#undef PG_STAGE_B
#undef PG_LDA
#undef PG_LDB
#undef PG_MMA
#undef PG_CAT8
#undef PG_WAIT_V
#undef PG_WAIT_L
#undef PG_BAR
#undef PG_SCHED
#undef PG_BSEL
}

struct EpiP2 {
    static constexpr bool PERM = true;
    bf16_t* O; float* SS; float* SA;
    __device__ __forceinline__ void operator()(f32x4 (&acc)[2][2][4][2], const Unit& u, int wr, int wc, int fr, int fq) const {
        const int row0 = u.pm * BM + wr * 64 + fr, col0 = u.pn * BM + wc * 32 + 8 * fq; const bool g = u.pn >= 10, st = u.pn >= 12, la = u.pn < 2; const int ln = fq * 16 + fr;
#pragma unroll
        for (int ai = 0; ai < 2; ++ai)
#pragma unroll
            for (int m = 0; m < 4; ++m) { const int row = row0 + ai * HALF + m * 16; bf16_t* rowp = O + (size_t)row * PLD + col0; float ssq = 0.f;
#pragma unroll
                for (int bj = 0; bj < 2; ++bj) { f32x4 v0 = acc[ai][bj][m][0], v1 = acc[ai][bj][m][1];
                    if (g) { v0 = gelu_tanh4(v0); v1 = gelu_tanh4(v1); }
                    if (st) { const f32x4 q = v0 * v0 + v1 * v1; ssq += (q[0] + q[1]) + (q[2] + q[3]); }
                    if (la) { float sl = 0.f;
#pragma unroll
                        for (int j = 0; j < 4; ++j) sl += v0[j] * v0[j] + v1[j] * v1[j];
                        sl += shx(sl, 16, ln); sl += shx(sl, 32, ln);
                        if (fq == 0) SA[(size_t)row * 16 + u.pn * 8 + bj * 4 + wc] = sl; }
                    u32x4 w; w.x = pk2(v0[0], v0[1]); w.y = pk2(v0[2], v0[3]); w.z = pk2(v1[0], v1[1]); w.w = pk2(v1[2], v1[3]);
                    *(u32x4*)(rowp + bj * HALF) = w; }
                if (st) { ssq += shx(ssq, 16, ln); ssq += shx(ssq, 32, ln);
                    if (fq == 0) SS[(size_t)row * 8 + (u.pn - 12) * 4 + wc] = ssq; } }
    }
};
struct EpiBf16 {
    static constexpr bool PERM = true;
    bf16_t* O; int ldc; int gelu_pn; float* SS;
    __device__ __forceinline__ void operator()(f32x4 (&acc)[2][2][4][2], const Unit& u, int wr, int wc, int fr, int fq) const {
        const int row0 = u.pm * BM + wr * 64 + fr, col0 = u.pn * BM + wc * 32 + 8 * fq; const bool g = u.pn >= gelu_pn, st = u.pn >= gelu_pn + 2;
#pragma unroll
        for (int ai = 0; ai < 2; ++ai)
#pragma unroll
            for (int m = 0; m < 4; ++m) { bf16_t* rowp = O + (size_t)(row0 + ai * HALF + m * 16) * ldc + col0; float ssq = 0.f;
#pragma unroll
                for (int bj = 0; bj < 2; ++bj) { f32x4 v0 = acc[ai][bj][m][0], v1 = acc[ai][bj][m][1];
                    if (g) { v0 = gelu_tanh4(v0); v1 = gelu_tanh4(v1); }
                    if (st) { const f32x4 q = v0 * v0 + v1 * v1; ssq += (q[0] + q[1]) + (q[2] + q[3]); }
                    u32x4 w; w.x = pk2(v0[0], v0[1]); w.y = pk2(v0[2], v0[3]); w.z = pk2(v1[0], v1[1]); w.w = pk2(v1[2], v1[3]);
                    *(u32x4*)(rowp + bj * HALF) = w; }
                if (st) { const int ln = fq * 16 + fr; ssq += shx(ssq, 16, ln); ssq += shx(ssq, 32, ln);
                    if (fq == 0) SS[(size_t)(row0 + ai * HALF + m * 16) * 8 + (u.pn - gelu_pn - 2) * 4 + wc] = ssq; } }
    }
};
}
using pg::Unit;

struct Args { const float* in[N_INPUTS]; float* out; unsigned char* ws; int ph_lo, ph_hi; };

struct Ctx {
    const float* const __attribute__((address_space(4)))* kin;
    unsigned char* ws; LAS unsigned char* lds; int tid, lane, wave, G, bid;
    __device__ __forceinline__ const float* in(int k) const { return (const float*)(const __attribute__((address_space(1))) float*)kin[k]; }
};

__device__ __forceinline__ void phase_prologue(const Ctx& C) {
    const float* cin = C.in(I_C); const float* cctx = C.in(I_CCTX); const float* modw = C.in(I_MODW); const float* modb = C.in(I_MODB);
    float* MOD = (float*)(C.ws + WS_MOD); float* ROPE = (float*)(C.ws + WS_ROPE);
    for (int i = C.bid * 512 + C.tid; i < 2048 * 16; i += C.G * 512) {
        const int pos = i >> 4, p = i & 15; const float inv = powf(10000.0f, -(float)(p & 7) / 8.0f);
        const float ang = (float)(p < 8 ? (pos >> 6) : (pos & 63)) * inv;
        ROPE[i] = cosf(ang); ROPE[32768 + i] = sinf(ang);
    }
    if (C.bid == 0 && C.wave == 0) {
        const int l = C.lane, i = l & 15, kb = l >> 4; pg::v8i32 A, B;
#pragma unroll
        for (int d = 0; d < 8; ++d) { unsigned wa = 0, wb = 0;
#pragma unroll
            for (int bb = 0; bb < 4; ++bb) { const int k = 32 * kb + 4 * d + bb; const int va = (i * 7 + k * 3) % 5, vb = (k * 5 + i * 11) % 3;
                wa |= (unsigned)(va == 0 ? 0 : va == 1 ? 0x38 : va == 2 ? 0x40 : va == 3 ? 0x44 : 0x48) << (8 * bb); wb |= (unsigned)(vb == 0 ? 0 : vb == 1 ? 0x38 : 0x40) << (8 * bb); }
            A[d] = (int)wa; B[d] = (int)wb; }
        f32x4 cz = {0.f, 0.f, 0.f, 0.f};
        const f32x4 got = __builtin_amdgcn_mfma_scale_f32_16x16x128_f8f6f4(A, B, cz, 0, 0, 0, pg::MX_SCALE_ONE, 0, pg::MX_SCALE_ONE);
        bool bad = pk4_fp8(1.f, 2.f, 3.f, 4.f) != 0x48444038u;
#pragma unroll
        for (int r = 0; r < 4; ++r) { const int row = 4 * kb + r; int e = 0; for (int k = 0; k < 128; ++k) e += ((row * 7 + k * 3) % 5) * ((k * 5 + i * 11) % 3); bad |= got[r] != (float)e; }
        const f32x4 got2 = __builtin_amdgcn_mfma_scale_f32_16x16x128_f8f6f4(A, B, cz, 0, 0, 0, pg::MX_SCALE_W, 0, pg::MX_SCALE_ONE);
#pragma unroll
        for (int r = 0; r < 4; ++r) bad |= got2[r] * 32.f != got[r];
        if (bad) __hip_atomic_store((unsigned*)(C.ws + WS_BAR + 49152), 1u, __ATOMIC_RELAXED, __HIP_MEMORY_SCOPE_AGENT);
    }
    LAS float* sA = (LAS float*)C.lds;
    for (int i = C.tid; i < 17 * 1024; i += 512) { const float v = i < 16384 ? cin[i] : cctx[i - 16384]; sA[i] = v * fast_sigmoid(v); }
    __syncthreads();
    LAS float* red = (LAS float*)(C.lds + 17 * 1024 * 4);
    for (int unit = C.bid; unit < DEPTH * 96; unit += C.G) {
        const int layer = unit / 96, col = (unit % 96) * 64 + C.lane;
        const float* W = modw + (size_t)layer * DM * 6144 + col;
        float acc[17];
#pragma unroll
        for (int b = 0; b < 17; ++b) acc[b] = 0.f;
        const int k0 = C.wave * 128;
        for (int k = k0; k < k0 + 128; k += 4) {
            float w[4];
#pragma unroll
            for (int j = 0; j < 4; ++j) w[j] = W[(size_t)(k + j) * 6144];
#pragma unroll
            for (int j = 0; j < 4; ++j)
#pragma unroll
                for (int b = 0; b < 17; ++b) acc[b] += sA[b * 1024 + k + j] * w[j];
        }
#pragma unroll
        for (int b = 0; b < 17; ++b) red[(C.wave * 17 + b) * 64 + C.lane] = acc[b];
        __syncthreads();
        for (int o = C.tid; o < 17 * 64; o += 512) { const int b = o >> 6, l = o & 63; float s = 0.f;
#pragma unroll
            for (int w8 = 0; w8 < 8; ++w8) s += red[(w8 * 17 + b) * 64 + l];
            const int cc = (unit % 96) * 64 + l;
            MOD[(size_t)layer * MODLD + (size_t)b * 6144 + cc] = s + modb[layer * 6144 + cc]; }
        __syncthreads();
    }
}

template <bool F8 = false>
__device__ __forceinline__ void cvt_t(const Ctx& C, const float* src, int lds_, int K, int N, bf16_t* dst, int ldd, const float* ks, int rmul, int radd, int& rot, int kshift = 30, size_t eblk = 0, float wscale = 32.f, int kvperm = 0) {
    LAS float* T = (LAS float*)C.lds;
    const int tk = K / 64, tn = (N + 63) / 64, ntile = tk * tn;
    int first = (C.bid - rot) % C.G; if (first < 0) first += C.G;
    const int tx = C.tid & 63, ty = C.tid >> 6;
    for (int t = first; t < ntile; t += 4 * C.G) {
        float v[4][8];
#pragma unroll
        for (int b = 0; b < 4; ++b) { const int tb = t + b * C.G;
            if (tb < ntile) { const int k0 = (tb % tk) * 64, n0 = (tb / tk) * 64;
#pragma unroll
                for (int r = 0; r < 2; ++r) { const int k = k0 + (C.tid >> 4) + 32 * r, n = n0 + (C.tid & 15) * 4; f32x4 x = {0.f, 0.f, 0.f, 0.f};
                    if (n < N) { x = *(const f32x4*)(src + (size_t)k * lds_ + n); if (ks) x *= ks[k]; } v[b][4 * r] = x[0]; v[b][4 * r + 1] = x[1]; v[b][4 * r + 2] = x[2]; v[b][4 * r + 3] = x[3]; } } }
#pragma unroll
        for (int b = 0; b < 4; ++b) { if (t + b * C.G < ntile) {
#pragma unroll
                for (int r = 0; r < 2; ++r)
#pragma unroll
                    for (int j = 0; j < 4; ++j) T[b * 4160 + ((C.tid >> 4) + 32 * r) * 65 + (C.tid & 15) * 4 + j] = v[b][4 * r + j]; } }
        __syncthreads();
#pragma unroll
        for (int b = 0; b < 4; ++b) { const int tb = t + b * C.G;
            if (tb < ntile) { const int k0 = (tb % tk) * 64, n0 = (tb / tk) * 64; const int n = C.tid >> 3, kc = (C.tid & 7) * 8;
                if (n0 + n < N) { float f[8];
#pragma unroll
                    for (int j = 0; j < 8; ++j) f[j] = T[b * 4160 + (kc + j) * 65 + n];
                    const int k = k0 + kc, nn = n0 + n;
                    const int drow = kvperm ? ((nn >> 8) * 256 + ((nn >> 5) & 1) * 128 + (((nn >> 7) & 1) * 2 + ((nn >> 6) & 1)) * 32 + (nn & 31)) : nn * rmul + radd;
                    const size_t off = (size_t)(k >> kshift) * eblk + (size_t)drow * ldd + (k & ((1 << kshift) - 1));
                    if constexpr (F8) { u32x2 w; w.x = pk4_fp8(wscale * f[0], wscale * f[1], wscale * f[2], wscale * f[3]); w.y = pk4_fp8(wscale * f[4], wscale * f[5], wscale * f[6], wscale * f[7]);
                        *(u32x2*)((unsigned char*)dst + off) = w; }
                    else { u32x4 w; w.x = pk2(f[0], f[1]); w.y = pk2(f[2], f[3]); w.z = pk2(f[4], f[5]); w.w = pk2(f[6], f[7]);
                        st16_wt(dst + off, w); } } } }
        __syncthreads();
    }
    rot = (rot + ntile) % C.G;
}
__device__ __forceinline__ void phase_cvt(const Ctx& C, int layer) {
    unsigned char* W = C.ws + WS_W; int rot = 0;
    const float* win = C.in(I_WIN) + (size_t)layer * DM * N_IN;
    bf16_t* WIN = (bf16_t*)(W + W_IN);
    cvt_t(C, win + CONV_OFF, N_IN, DM, 3072, WIN + (size_t)512 * DM, DM, nullptr, 1, 0, rot);
    cvt_t<true>(C, win + GATE_OFF, N_IN, DM, 4096, (bf16_t*)(W + W_G), DM, nullptr, 1, 0, rot, 30, 0, -46.16624130844683f);
    cvt_t(C, C.in(I_W1) + (size_t)layer * 16 * DM * 256, 256, 16 * DM, 256, (bf16_t*)(W + W_13), DM, nullptr, 2, 0, rot, 10, (size_t)512 * DM);
    cvt_t(C, C.in(I_W3) + (size_t)layer * 16 * DM * 256, 256, 16 * DM, 256, (bf16_t*)(W + W_13), DM, nullptr, 2, 1, rot, 10, (size_t)512 * DM);
    cvt_t(C, C.in(I_W2) + (size_t)layer * 16 * 256 * DM, DM, 16 * 256, DM, (bf16_t*)(W + W_2), 256, nullptr, 1, 0, rot, 8, (size_t)DM * 256);
    cvt_t(C, C.in(I_WO) + (size_t)layer * DM * DM, DM, DM, DM, (bf16_t*)(W + W_O), DM, nullptr, 1, 0, rot);
    cvt_t(C, win, N_IN, DM, 416, WIN, DM, nullptr, 1, 0, rot);
    cvt_t(C, C.in(I_WUQ) + (size_t)layer * 256 * 768, 768, 256, 768, (bf16_t*)(W + W_UQ), 256, C.in(I_QAG) + layer * 256, 1, 0, rot);
    cvt_t(C, C.in(I_WUKV) + (size_t)layer * 128 * 1024, 1024, 128, 1024, (bf16_t*)(W + W_UKV), 256, C.in(I_KVG) + layer * 128, 1, 0, rot, 30, 0, 32.f, 1);
    for (int n = 0; n < 4; ++n) if (n != 2)
        cvt_t<true>(C, C.in(I_WBR) + ((size_t)layer * 4 + n) * 512 * DM, DM, 512, DM, (bf16_t*)(W + W_B + (size_t)n * DM * 512), 512, nullptr, 1, 0, rot);
    const int gt = C.bid * 512 + C.tid, gs = C.G * 512;
    unsigned zz = 0u; asm volatile("" : "+v"(zz)); const u32x4 zero4 = {zz, zz, zz, zz};
    for (int i = gt; i < 96 * DM / 8; i += gs) *(u32x4*)(WIN + (size_t)416 * DM + (size_t)i * 8) = zero4;
    for (int i = gt; i < 1024 * 16; i += gs) { const int n = i >> 4, kc = (i & 15) * 8; *(u32x4*)((bf16_t*)(W + W_UKV) + (size_t)n * 256 + 128 + kc) = zero4; }
    { const float* sw = C.in(I_SGUW) + (size_t)layer * 4 * 128 * 128; bf16_t* d = (bf16_t*)(W + W_SGU);
      for (int i = gt; i < 4 * 128 * 128 / 2; i += gs) *(unsigned*)(d + i * 2) = pk2(sw[i * 2], sw[i * 2 + 1]); }
    { const float* pw = C.in(I_POOLW) + (size_t)layer * 4 * 128 * 128; const float* ps = C.in(I_POOLS) + layer * 512; const float* wb = C.in(I_WBR) + ((size_t)layer * 4 + 2) * 512 * DM;
      unsigned char* d = W + W_B + (size_t)2 * DM * 512;
      for (int o = gt; o < 512 * DM / 4; o += gs) { const int dd = (o & 255) * 4, kc = o >> 8, g = kc >> 7; const float* pwr = pw + (size_t)kc * 128; const float* psg = ps + g * 128; const float* wbg = wb + (size_t)g * 128 * DM + dd;
          f32x4 sacc = {0.f, 0.f, 0.f, 0.f};
#pragma unroll 8
          for (int j = 0; j < 128; ++j) { const float cf = pwr[j] * psg[j]; const f32x4 wv = *(const f32x4*)(wbg + (size_t)j * DM); sacc += cf * wv; }
#pragma unroll
          for (int q = 0; q < 4; ++q) d[(size_t)(dd + q) * 512 + kc] = (unsigned char)(pk4_fp8(32.f * sacc[q], 0.f, 0.f, 0.f) & 0xffu); } }
}

__device__ __forceinline__ const float* xrow_c(const float* xl, const float* xc, int r) { const int b = r / TPB, t = r - b * TPB; return t < CTX ? xc + (size_t)(b * CTX + t) * DM : xl + (size_t)(b * LAT + t - CTX) * DM; }
__device__ __forceinline__ float* xrow(float* xl, float* xc, int r) { const int b = r / TPB, t = r - b * TPB; return t < CTX ? xc + (size_t)(b * CTX + t) * DM : xl + (size_t)(b * LAT + t - CTX) * DM; }
__device__ __forceinline__ int mod_index(int r) { const int b = r / TPB, t = r - b * TPB; return t < CTX ? 16 : b; }

struct NormRaw { u32x4 a0, a1, a2, a3, y0, y1; };
__device__ __forceinline__ void norm_load(NormRaw& R, const float* xf, const bf16_t* xb, const bf16_t* y, int lane) {
    if (xf) { R.a0 = *(const u32x4*)(xf + 8 * lane); R.a1 = *(const u32x4*)(xf + 8 * lane + 4); R.a2 = *(const u32x4*)(xf + 512 + 8 * lane); R.a3 = *(const u32x4*)(xf + 516 + 8 * lane); }
    else { R.a0 = *(const u32x4*)(xb + 8 * lane); R.a1 = *(const u32x4*)(xb + 512 + 8 * lane); R.a2 = R.a0; R.a3 = R.a1; }
    if (y) { R.y0 = *(const u32x4*)(y + 8 * lane); R.y1 = *(const u32x4*)(y + 512 + 8 * lane); } else { R.y0 = R.a0; R.y1 = R.a1; }
}
__device__ __forceinline__ void store_h_wt(bf16_t* hrow, int lane, const float (&h)[16]) {
    u32x4 w0, w1; w0.x = pk2(h[0], h[1]); w0.y = pk2(h[2], h[3]); w0.z = pk2(h[4], h[5]); w0.w = pk2(h[6], h[7]);
    w1.x = pk2(h[8], h[9]); w1.y = pk2(h[10], h[11]); w1.z = pk2(h[12], h[13]); w1.w = pk2(h[14], h[15]);
    st16_wt(hrow + 8 * lane, w0); st16_wt(hrow + 512 + 8 * lane, w1);
}
__device__ __forceinline__ void store_h(bf16_t* hrow, int lane, const float (&h)[16]) {
    u32x4 w0, w1; w0.x = pk2(h[0], h[1]); w0.y = pk2(h[2], h[3]); w0.z = pk2(h[4], h[5]); w0.w = pk2(h[6], h[7]);
    w1.x = pk2(h[8], h[9]); w1.y = pk2(h[10], h[11]); w1.z = pk2(h[12], h[13]); w1.w = pk2(h[14], h[15]);
    *(u32x4*)(hrow + 8 * lane) = w0; *(u32x4*)(hrow + 512 + 8 * lane) = w1;
}
__device__ __forceinline__ void norm_finish(const NormRaw& R, bool x_f32, bool has_y, const float* gate, bf16_t* xdst, const float* g, const float* shift, const float* scale, int lane, float (&h)[16]) {
    float v[16];
    if (x_f32) { const f32x4 f0 = __builtin_bit_cast(f32x4, R.a0), f1 = __builtin_bit_cast(f32x4, R.a1), f2 = __builtin_bit_cast(f32x4, R.a2), f3 = __builtin_bit_cast(f32x4, R.a3);
        v[0] = f0[0]; v[1] = f0[1]; v[2] = f0[2]; v[3] = f0[3]; v[4] = f1[0]; v[5] = f1[1]; v[6] = f1[2]; v[7] = f1[3];
        v[8] = f2[0]; v[9] = f2[1]; v[10] = f2[2]; v[11] = f2[3]; v[12] = f3[0]; v[13] = f3[1]; v[14] = f3[2]; v[15] = f3[3];
    } else { float t[8]; unpack8(R.a0, t);
#pragma unroll
        for (int j = 0; j < 8; ++j) v[j] = t[j];
        unpack8(R.a1, t);
#pragma unroll
        for (int j = 0; j < 8; ++j) v[8 + j] = t[j]; }
    if (has_y) {
        float yf[16]; { float t[8]; unpack8(R.y0, t);
#pragma unroll
            for (int j = 0; j < 8; ++j) yf[j] = t[j];
            unpack8(R.y1, t);
#pragma unroll
            for (int j = 0; j < 8; ++j) yf[8 + j] = t[j]; }
#pragma unroll
        for (int q = 0; q < 4; ++q) { const int c = (q >> 1) * 512 + 8 * lane + (q & 1) * 4; const f32x4 gt = *(const f32x4*)(gate + c);
#pragma unroll
            for (int j = 0; j < 4; ++j) v[q * 4 + j] += gt[j] * yf[q * 4 + j]; }
    }
    if (xdst) store_h(xdst, lane, v);
    float ss = 0.f;
#pragma unroll
    for (int j = 0; j < 16; ++j) ss += v[j] * v[j];
    ss = wave_sum(ss, lane);
    const float rstd = 1.0f / sqrtf(ss * (1.0f / 1024.0f) + EPS);
#pragma unroll
    for (int q = 0; q < 4; ++q) { const int c = (q >> 1) * 512 + 8 * lane + (q & 1) * 4;
        const f32x4 gg = *(const f32x4*)(g + c), sh = *(const f32x4*)(shift + c), sc = *(const f32x4*)(scale + c);
#pragma unroll
        for (int j = 0; j < 4; ++j) h[q * 4 + j] = v[q * 4 + j] * rstd * gg[j] * (1.0f + sc[j]) + sh[j]; }
}
__device__ __forceinline__ void store_h8(unsigned char* hrow, int lane, const float (&h)[16]) {
    u32x2 a, b; a.x = pk4_fp8(h[0], h[1], h[2], h[3]); a.y = pk4_fp8(h[4], h[5], h[6], h[7]); b.x = pk4_fp8(h[8], h[9], h[10], h[11]); b.y = pk4_fp8(h[12], h[13], h[14], h[15]);
    const bool odd = lane & 1; const unsigned sx = odd ? a.x : b.x, sy = odd ? a.y : b.y;
    const unsigned rx = (unsigned)__builtin_amdgcn_update_dpp(0, (int)sx, 0xB1, 0xf, 0xf, false), ry = (unsigned)__builtin_amdgcn_update_dpp(0, (int)sy, 0xB1, 0xf, 0xf, false);
    const u32x4 w = odd ? (u32x4){rx, ry, b.x, b.y} : (u32x4){a.x, a.y, rx, ry};
    st16_wt(hrow + (odd ? 512 + 8 * (lane - 1) : 8 * lane), w);
}
__device__ __forceinline__ void phase_norm1(const Ctx& C, int layer, bf16_t* XB) {
    const float* g = C.in(I_N1G) + layer * DM; const float* MOD = (const float*)(C.ws + WS_MOD) + (size_t)layer * MODLD; bf16_t* H = (bf16_t*)(C.ws + WS_H);
    const bf16_t* Y = (const bf16_t*)(C.ws + WS_MIX + MIX_OUT); const float* xin = C.in(I_X); const float* cin = C.in(I_CTX);
    const int rows_per = NTOK / C.G, rbase = C.bid * rows_per + 2 * C.wave;
    int mi_cur = -1; float Av[16], Sv[16], Gv[16];
    for (int k = 0; k < rows_per / 16; ++k) {
        const int r0 = rbase + 16 * k;
        NormRaw R[2];
#pragma unroll
        for (int q = 0; q < 2; ++q) norm_load(R[q], layer == 0 ? xrow_c(xin, cin, r0 + q) : nullptr, XB + (size_t)(r0 + q) * DM, layer == 0 ? nullptr : Y + (size_t)(r0 + q) * DM, C.lane);
#pragma unroll
        for (int q = 0; q < 2; ++q) { const int r = r0 + q; const int mi = mod_index(r);
            if (mi != mi_cur) { mi_cur = mi; const float* m = MOD + (size_t)mi * 6144;
#pragma unroll
                for (int qq = 0; qq < 4; ++qq) { const int c = (qq >> 1) * 512 + 8 * C.lane + (qq & 1) * 4; const f32x4 gg = *(const f32x4*)(g + c), sh = *(const f32x4*)(m + c), sc = *(const f32x4*)(m + DM + c);
                    f32x4 gt = {0.f, 0.f, 0.f, 0.f}; if (layer != 0) gt = *(const f32x4*)(m - MODLD + 5 * DM + c);
#pragma unroll
                    for (int j = 0; j < 4; ++j) { Av[qq * 4 + j] = gg[j] * (1.0f + sc[j]); Sv[qq * 4 + j] = sh[j]; Gv[qq * 4 + j] = gt[j]; } } }
            float v[16], h[16];
            if (layer == 0) { const f32x4 f0 = __builtin_bit_cast(f32x4, R[q].a0), f1 = __builtin_bit_cast(f32x4, R[q].a1), f2 = __builtin_bit_cast(f32x4, R[q].a2), f3 = __builtin_bit_cast(f32x4, R[q].a3);
                v[0] = f0[0]; v[1] = f0[1]; v[2] = f0[2]; v[3] = f0[3]; v[4] = f1[0]; v[5] = f1[1]; v[6] = f1[2]; v[7] = f1[3];
                v[8] = f2[0]; v[9] = f2[1]; v[10] = f2[2]; v[11] = f2[3]; v[12] = f3[0]; v[13] = f3[1]; v[14] = f3[2]; v[15] = f3[3];
            } else { float t[8], yf[8]; unpack8(R[q].a0, t); unpack8(R[q].y0, yf);
#pragma unroll
                for (int j = 0; j < 8; ++j) v[j] = t[j] + Gv[j] * yf[j];
                unpack8(R[q].a1, t); unpack8(R[q].y1, yf);
#pragma unroll
                for (int j = 0; j < 8; ++j) v[8 + j] = t[j] + Gv[8 + j] * yf[j];
                store_h_wt(XB + (size_t)r * DM, C.lane, v); }
            float ss = 0.f;
#pragma unroll
            for (int j = 0; j < 16; ++j) ss += v[j] * v[j];
            ss = wave_sum(ss, C.lane);
            const float rstd = 1.0f / sqrtf(ss * (1.0f / 1024.0f) + EPS);
#pragma unroll
            for (int j = 0; j < 16; ++j) h[j] = v[j] * rstd * Av[j] + Sv[j];
            store_h_wt(H + (size_t)r * DM, C.lane, h); store_h8(C.ws + WS_H8 + (size_t)r * DM, C.lane, h); asm volatile("" ::: "memory"); }
    }
}
__device__ __forceinline__ void phase_final(const Ctx& C, float* __restrict__ out, const bf16_t* __restrict__ XB) {
    const bool poison = __hip_atomic_load((const unsigned*)(C.ws + WS_BAR + 49152), __ATOMIC_RELAXED, __HIP_MEMORY_SCOPE_AGENT) != 0u;
    const float* __restrict__ MOD = (const float*)(C.ws + WS_MOD) + (size_t)(DEPTH - 1) * MODLD; const bf16_t* __restrict__ Y = (const bf16_t*)(C.ws + WS_MIX + MIX_OUT);
    const int rows_per = NB * LAT / C.G, c0 = (C.tid & 127) * 8, b = (C.bid * rows_per) / LAT;
    const float* gt = MOD + (size_t)b * 6144 + 5 * DM + c0; const f32x4 g0 = *(const f32x4*)gt, g1 = *(const f32x4*)(gt + 4);
#pragma unroll 4
    for (int k = (C.tid >> 7); k < rows_per; k += 4) {
        const int lr = C.bid * rows_per + k, t = lr - b * LAT, r = b * TPB + CTX + t;
        float* xp = out + (size_t)lr * DM + c0; float yf[8], xf[8]; unpack8(*(const u32x4*)(Y + (size_t)r * DM + c0), yf); unpack8(*(const u32x4*)(XB + (size_t)r * DM + c0), xf);
        *(f32x4*)xp = (f32x4){xf[0] + g0[0] * yf[0], xf[1] + g0[1] * yf[1], xf[2] + g0[2] * yf[2], xf[3] + g0[3] * yf[3]};
        *(f32x4*)(xp + 4) = (f32x4){xf[4] + g1[0] * yf[4], xf[5] + g1[1] * yf[5], xf[6] + g1[2] * yf[6], xf[7] + g1[3] * yf[7]};
        if (poison) { const float qn = __builtin_nanf(""); *(f32x4*)xp = (f32x4){qn, qn, qn, qn}; *(f32x4*)(xp + 4) = (f32x4){qn, qn, qn, qn}; }
    }
}

__device__ __forceinline__ void seq_pos(int r, int& t, int& L) { const int tt = r % TPB; if (tt < CTX) { t = tt; L = CTX; } else { t = tt - CTX; L = LAT; } }
__device__ __forceinline__ void phase_conv(const Ctx& C, int layer, int half) {
    const bf16_t* Pg = (const bf16_t*)(C.ws + WS_MIX + MIX_P); unsigned char* BR = C.ws + WS_BR; const float* cw = C.in(I_CONVW) + layer * 3 * 512;
    float cw0[8], cw1[8], cw2[8];
    { const int c0 = (C.tid & 63) * 8;
#pragma unroll
      for (int j = 0; j < 8; ++j) { cw0[j] = cw[c0 + j]; cw1[j] = cw[512 + c0 + j]; cw2[j] = cw[1024 + c0 + j]; } }
    for (int it = C.bid * 512 + C.tid; it < (HROWS / 2) * 64; it += C.G * 512) {
        const int lr = (it >> 6) * 2, c0 = (it & 63) * 8, r = half * HROWS + lr; int t, L; seq_pos(r, t, L);
        const bf16_t* p = Pg + (size_t)lr * PLD;
        const bool hasp = t > 0, hasn = t + 2 < L;
        const bf16_t* pp = hasp ? p - PLD : p; const bf16_t* pn = hasn ? p + 2 * PLD : p;
        const u32x4 g0 = *(const u32x4*)(p + 512 + c0), g1 = *(const u32x4*)(p + PLD + 512 + c0);
        const u32x4 a0 = *(const u32x4*)(pp + 1024 + c0), b0 = *(const u32x4*)(pp + 1536 + c0), a1 = *(const u32x4*)(p + 1024 + c0), b1 = *(const u32x4*)(p + 1536 + c0);
        const u32x4 a2 = *(const u32x4*)(p + PLD + 1024 + c0), b2 = *(const u32x4*)(p + PLD + 1536 + c0), a3 = *(const u32x4*)(pn + 1024 + c0), b3 = *(const u32x4*)(pn + 1536 + c0);
        float x0[8], x1[8], x2[8], x3[8], fa[8], fb[8], gb0[8], gb1[8];
        unpack8(a0, fa); unpack8(b0, fb);
#pragma unroll
        for (int j = 0; j < 8; ++j) x0[j] = hasp ? fa[j] * fb[j] : 0.f;
        unpack8(a1, fa); unpack8(b1, fb);
#pragma unroll
        for (int j = 0; j < 8; ++j) x1[j] = fa[j] * fb[j];
        unpack8(a2, fa); unpack8(b2, fb);
#pragma unroll
        for (int j = 0; j < 8; ++j) x2[j] = fa[j] * fb[j];
        unpack8(a3, fa); unpack8(b3, fb);
#pragma unroll
        for (int j = 0; j < 8; ++j) x3[j] = hasn ? fa[j] * fb[j] : 0.f;
        unpack8(g0, gb0); unpack8(g1, gb1);
        float o0[8], o1[8];
#pragma unroll
        for (int j = 0; j < 8; ++j) { const float w0 = cw0[j], w1 = cw1[j], w2 = cw2[j];
            o0[j] = gb0[j] * (w0 * x0[j] + w1 * x1[j] + w2 * x2[j]); o1[j] = gb1[j] * (w0 * x1[j] + w1 * x2[j] + w2 * x3[j]); }
        u32x2 wa, wb; wa.x = pk4_fp8(o0[0], o0[1], o0[2], o0[3]); wa.y = pk4_fp8(o0[4], o0[5], o0[6], o0[7]); wb.x = pk4_fp8(o1[0], o1[1], o1[2], o1[3]); wb.y = pk4_fp8(o1[4], o1[5], o1[6], o1[7]);
        const bool odd = it & 1; const unsigned sx = odd ? wa.x : wb.x, sy = odd ? wa.y : wb.y;
        const unsigned rx = (unsigned)__builtin_amdgcn_update_dpp(0, (int)sx, 0xB1, 0xf, 0xf, false), ry = (unsigned)__builtin_amdgcn_update_dpp(0, (int)sy, 0xB1, 0xf, 0xf, false);
        const u32x4 w = odd ? (u32x4){rx, ry, wb.x, wb.y} : (u32x4){wa.x, wa.y, rx, ry};
        *(u32x4*)(BR + (size_t)(r + (odd ? 1 : 0)) * 2048 + 512 + (c0 & ~15)) = w;
    }
}
template <int GI, int R>
__device__ __forceinline__ void pool_rows(const bf16_t* Pg, unsigned char* BR, int half, int lr, int li) {
    constexpr int W = 2 << GI, H = W / 2, NR = R + W - 1;
    const int c0 = GI * 128 + (li & 15) * 8, r = half * HROWS + lr; int t, L; seq_pos(r, t, L);
    const unsigned char* pb = (const unsigned char*)Pg; const unsigned ob = (unsigned)(2048 + c0) * 2u;
    u32x4 v[NR];
#pragma unroll
    for (int k = 0; k < NR; ++k) { const int q = t - H + k; const int qc = min(max(q, 0), L - 1); v[k] = *(const u32x4*)(pb + ((unsigned)(lr + qc - t) * (unsigned)(PLD * 2) + ob)); }
    float s8[8], f[8];
#pragma unroll
    for (int j = 0; j < 8; ++j) s8[j] = 0.f;
#pragma unroll
    for (int k = 0; k < W; ++k) { const int q = t - H + k; const float wt = (q >= 0 && q < L) ? 1.f : 0.f; unpack8(v[k], f);
#pragma unroll
        for (int j = 0; j < 8; ++j) s8[j] += wt * f[j]; }
    unsigned wx[R], wy[R];
#pragma unroll
    for (int i = 0; i < R; ++i) {
        if (i > 0) {
            const int ql = t - H + i - 1, qe = t + H + i - 1; const float wl = (ql >= 0) ? -1.f : 0.f, we = (qe < L) ? 1.f : 0.f;
            unpack8(v[i - 1], f);
#pragma unroll
            for (int j = 0; j < 8; ++j) s8[j] += wl * f[j];
            unpack8(v[i + W - 1], f);
#pragma unroll
            for (int j = 0; j < 8; ++j) s8[j] += we * f[j];
        }
        const int ti = t + i, lo = max(ti - H, 0), hi = min(ti + H, L); const float inv = __builtin_amdgcn_rcpf((float)(hi - lo));
        unpack8(v[i + H], f);
        float o[8];
#pragma unroll
        for (int j = 0; j < 8; ++j) o[j] = s8[j] * inv - f[j];
        wx[i] = pk4_fp8(o[0], o[1], o[2], o[3]); wy[i] = pk4_fp8(o[4], o[5], o[6], o[7]);
    }
    const bool odd = li & 1; unsigned char* dst = BR + (size_t)(r + (odd ? R / 2 : 0)) * 2048 + 1024 + (c0 & ~15);
#pragma unroll
    for (int i = 0; i < R / 2; ++i) {
        const unsigned sx = odd ? wx[i] : wx[R / 2 + i], sy = odd ? wy[i] : wy[R / 2 + i];
        const unsigned rx = (unsigned)__builtin_amdgcn_update_dpp(0, (int)sx, 0xB1, 0xf, 0xf, false), ry = (unsigned)__builtin_amdgcn_update_dpp(0, (int)sy, 0xB1, 0xf, 0xf, false);
        *(u32x4*)(dst + (size_t)i * 2048) = odd ? (u32x4){rx, ry, wx[R / 2 + i], wy[R / 2 + i]} : (u32x4){wx[i], wy[i], rx, ry};
    }
}
template <int GI>
__device__ __forceinline__ void pool_item(const bf16_t* Pg, unsigned char* BR, int half, int li) {
    const int lr = (li >> 4) * 8;
    if constexpr (GI < 3) pool_rows<GI, 8>(Pg, BR, half, lr, li);
    else { pool_rows<GI, 4>(Pg, BR, half, lr, li); asm volatile("" ::: "memory"); pool_rows<GI, 4>(Pg, BR, half, lr + 4, li); }
}
__device__ __forceinline__ void phase_pool(const Ctx& C, int half) {
    const bf16_t* Pg = (const bf16_t*)(C.ws + WS_MIX + MIX_P); unsigned char* BR = C.ws + WS_BR;
    constexpr int NW = (HROWS / 8) * 16 / 64;
    for (int wi = C.bid + C.G * C.wave; wi < 4 * NW; wi += C.G * 8) {
        const int g = __builtin_amdgcn_readfirstlane(wi / NW), li = (wi - g * NW) * 64 + C.lane;
        if (g == 0) pool_item<0>(Pg, BR, half, li); else if (g == 1) pool_item<1>(Pg, BR, half, li); else if (g == 2) pool_item<2>(Pg, BR, half, li); else pool_item<3>(Pg, BR, half, li);
    }
}
__device__ __forceinline__ void phase_sgu(const Ctx& C, int layer, int half) {
    const bf16_t* Pg = (const bf16_t*)(C.ws + WS_MIX + MIX_P); unsigned char* BR = C.ws + WS_BR; const float* SS = (const float*)(C.ws + WS_SS);
    const bf16_t* Wg = (const bf16_t*)(C.ws + WS_W + W_SGU); const float* gain = C.in(I_SGUNG) + layer * 512; const float* bias = C.in(I_SGUB) + layer * 512;
    const int fr = C.lane & 15, fq = C.lane >> 4;
    int par = 0;
    __syncthreads();
    for (int unit = C.bid; unit < (HROWS / 128) * 4; unit += C.G, par ^= 1) {
        const int ch = unit >> 2, g = unit & 3, lr0 = ch * 128;
        LAS unsigned char* vT = C.lds + par * 34816;
        LAS float* rs = (LAS float*)(C.lds + 69632) + par * 128;
        u32x4 va[2], vb[2];
#pragma unroll
        for (int j = 0; j < 2; ++j) { const int id = C.tid + 512 * j, qp = id >> 4, cc = (id & 15) * 8; const bf16_t* src = Pg + (size_t)(lr0 + 2 * qp) * PLD + 3072 + g * 128 + cc;
            va[j] = *(const u32x4*)src; vb[j] = *(const u32x4*)(src + PLD); }
        const int p = C.wave * 16 + fr;
        bf16x8 af[4];
#pragma unroll
        for (int ks = 0; ks < 4; ++ks) af[ks] = *(const bf16x8*)(Wg + ((size_t)g * 128 + p) * 128 + ks * 32 + fq * 8);
        u32x4 uq[4];
#pragma unroll
        for (int i = 0; i < 4; ++i) uq[i] = *(const u32x4*)(Pg + (size_t)(lr0 + p) * PLD + 2560 + g * 128 + fq * 32 + i * 8);
        const float bp = bias[g * 128 + p];
        if (C.tid < 128) { const f32x4 s0 = *(const f32x4*)(SS + (size_t)(lr0 + C.tid) * 8), s1 = *(const f32x4*)(SS + (size_t)(lr0 + C.tid) * 8 + 4);
            rs[C.tid] = 1.0f / sqrtf((((s0[0] + s0[1]) + (s0[2] + s0[3])) + ((s1[0] + s1[1]) + (s1[2] + s1[3]))) * (1.0f / 512.0f) + EPS); }
        __syncthreads();
#pragma unroll
        for (int j = 0; j < 2; ++j) { const int id = C.tid + 512 * j, qp = id >> 4, cc = (id & 15) * 8; const float r0 = rs[2 * qp], r1 = rs[2 * qp + 1]; float f0[8], f1[8];
            unpack8(va[j], f0); unpack8(vb[j], f1);
            const f32x4 g0 = *(const f32x4*)(gain + g * 128 + cc), g1 = *(const f32x4*)(gain + g * 128 + cc + 4);
            const float gn[8] = {g0[0], g0[1], g0[2], g0[3], g1[0], g1[1], g1[2], g1[3]};
            LAS unsigned char* wp = vT + (((qp >> 2) ^ ((cc >> 3) & 15)) * 16 + (qp & 3) * 4);
#pragma unroll
            for (int e = 0; e < 8; ++e) *(LAS unsigned*)(wp + (cc + e) * 272) = pk2(f0[e] * r0 * gn[e], f1[e] * r1 * gn[e]); }
        __syncthreads();
        const int r = half * HROWS + lr0 + p;
        unsigned ob[8];
#pragma unroll
        for (int ct = 0; ct < 8; ++ct) {
            f32x4 acc = {0.f, 0.f, 0.f, 0.f}; const int c = (fr >> 2) * 32 + ct * 4 + (fr & 3);
#pragma unroll
            for (int ks = 0; ks < 4; ++ks) { const bf16x8 bfr = *(const LAS bf16x8*)(vT + c * 272 + (((ks * 4 + fq) ^ ((c >> 3) & 15)) * 16));
                acc = __builtin_amdgcn_mfma_f32_16x16x32_bf16(bfr, af[ks], acc, 0, 0, 0); }
            const unsigned ux = uq[ct >> 1][(ct & 1) * 2], uy = uq[ct >> 1][(ct & 1) * 2 + 1];
            ob[ct] = pk4_fp8(bflo(ux) * (acc[0] + bp), bfhi(ux) * (acc[1] + bp), bflo(uy) * (acc[2] + bp), bfhi(uy) * (acc[3] + bp));
        }
        { unsigned char* op = BR + (size_t)r * 2048 + 1536 + g * 128 + fq * 32;
          *(u32x4*)op = (u32x4){ob[0], ob[1], ob[2], ob[3]}; *(u32x4*)(op + 16) = (u32x4){ob[4], ob[5], ob[6], ob[7]}; }
    }
}

namespace att {
constexpr int SHM_V = 8192, SHM_K = 16384;
#define KSWZ(row, colB) ((row) * 256 + ((colB) ^ (((row) & 15) << 4)))
#define SBAR() __builtin_amdgcn_sched_barrier(0)
__device__ __forceinline__ int crow(int r, int hi) { return (r & 3) + 8 * (r >> 2) + 4 * hi; }
__device__ __forceinline__ void expA(f32x16& p0) {
#pragma unroll
    for (int r = 0; r < 16; ++r) p0[r] = __builtin_amdgcn_exp2f(p0[r]);
}
__device__ __forceinline__ void finishSM(f32x16& p0, f32x16& p1, float& l_reg, bf16x8& pa0, bf16x8& pa1, bf16x8& pa2, bf16x8& pa3) {
#pragma unroll
    for (int r = 0; r < 16; ++r) p1[r] = __builtin_amdgcn_exp2f(p1[r]);
    f32x2 s2 = {0.f, 0.f};
#pragma unroll
    for (int r = 0; r < 8; ++r) s2 += (f32x2){p0[2 * r], p0[2 * r + 1]};
#pragma unroll
    for (int r = 0; r < 8; ++r) s2 += (f32x2){p1[2 * r], p1[2 * r + 1]};
    float ps = s2.x + s2.y;
    { auto rr = __builtin_amdgcn_permlane32_swap(__float_as_uint(ps), __float_as_uint(ps), false, false); ps = __uint_as_float(rr[0]) + __uint_as_float(rr[1]); }
    l_reg += ps;
#define PK4(P, BASE, OUT) do { unsigned a0 = pk2(P[BASE + 0], P[BASE + 1]), a1 = pk2(P[BASE + 2], P[BASE + 3]);   \
    unsigned b0 = pk2(P[BASE + 4], P[BASE + 5]), b1 = pk2(P[BASE + 6], P[BASE + 7]);                              \
    auto r0 = __builtin_amdgcn_permlane32_swap(a0, b0, false, false); auto r1 = __builtin_amdgcn_permlane32_swap(a1, b1, false, false); \
    u32x4 w = {r0[0], r1[0], r0[1], r1[1]}; OUT = __builtin_bit_cast(bf16x8, w); } while (0)
    PK4(p0, 0, pa0); PK4(p0, 8, pa1); PK4(p1, 0, pa2); PK4(p1, 8, pa3);
#undef PK4
}
__device__ __forceinline__ void qkt(f32x16& p0, f32x16& p1, const LAS unsigned char* Ks, const bf16x8* qr, int r32, int hi, float negc) {
#pragma unroll
    for (int r = 0; r < 16; ++r) { p0[r] = negc; p1[r] = negc; }
#pragma unroll
    for (int d0 = 0; d0 < 6; ++d0) { const int cb = (d0 * 16 + hi * 8) * 2;
        const bf16x8 b0 = *(const LAS bf16x8*)(Ks + KSWZ(r32, cb));
        const bf16x8 b1 = *(const LAS bf16x8*)(Ks + KSWZ(32 + r32, cb));
        p0 = __builtin_amdgcn_mfma_f32_32x32x16_bf16(b0, qr[d0], p0, 0, 0, 0);
        p1 = __builtin_amdgcn_mfma_f32_32x32x16_bf16(b1, qr[d0], p1, 0, 0, 0); }
}
__device__ __forceinline__ int v_st(int k, int c) { const int kk = (k & ~0xC) | ((k & 4) << 1) | ((k & 8) >> 1); return ((kk >> 3) * 2 + (c >> 5)) * 512 + ((kk & 7) * 32 + (c & 31)) * 2; }
__device__ __forceinline__ int v_rd_base(int lane) { return ((lane & 3) << 3) | (((lane >> 2) & 3) << 6) | (((lane >> 4) & 1) << 5) | (((lane >> 5) & 1) << 8); }
constexpr int v_rd_off(int d0, int ks, int half) { return d0 * 512 + ks * 2048 + half * 1024; }
template <int OFF> __device__ __forceinline__ s16x4 tr_read(int vb) { s16x4 r; asm volatile("ds_read_b64_tr_b16 %0, %1 offset:%2" : "=&v"(r) : "v"(vb), "i"(OFF) : "memory"); return r; }
template <int D0> __device__ __forceinline__ void pv_one(f32x16& od, int vb, bf16x8 pa0, bf16x8 pa1, bf16x8 pa2, bf16x8 pa3) {
    const s16x4 l0 = tr_read<v_rd_off(D0, 0, 0)>(vb), h0 = tr_read<v_rd_off(D0, 0, 1)>(vb), l1 = tr_read<v_rd_off(D0, 1, 0)>(vb), h1 = tr_read<v_rd_off(D0, 1, 1)>(vb);
    const s16x4 l2 = tr_read<v_rd_off(D0, 2, 0)>(vb), h2 = tr_read<v_rd_off(D0, 2, 1)>(vb), l3 = tr_read<v_rd_off(D0, 3, 0)>(vb), h3 = tr_read<v_rd_off(D0, 3, 1)>(vb);
    asm volatile("s_waitcnt lgkmcnt(0)" ::: "memory"); SBAR();
#define PKV(L, H) (bf16x8){L[0], L[1], L[2], L[3], H[0], H[1], H[2], H[3]}
    od = __builtin_amdgcn_mfma_f32_32x32x16_bf16(pa0, PKV(l0, h0), od, 0, 0, 0);
    od = __builtin_amdgcn_mfma_f32_32x32x16_bf16(pa1, PKV(l1, h1), od, 0, 0, 0);
    od = __builtin_amdgcn_mfma_f32_32x32x16_bf16(pa2, PKV(l2, h2), od, 0, 0, 0);
    od = __builtin_amdgcn_mfma_f32_32x32x16_bf16(pa3, PKV(l3, h3), od, 0, 0, 0);
#undef PKV
}
__device__ __forceinline__ void attn_body(const bf16_t* __restrict__ Qb, const bf16_t* __restrict__ Kh, const bf16_t* __restrict__ Vh, unsigned char* __restrict__ Ob, int seq, LAS unsigned char* lds, const int tid, const float negc,
                                          const float* __restrict__ rqrow, const float* __restrict__ qgain, const float* __restrict__ rope_cs, int qpos) {
    const int wid = tid >> 6, lane = tid & 63, r32 = lane & 31, hi = lane >> 5;
    LAS unsigned char* V_lds = lds; LAS unsigned char* K_lds = lds + 2 * SHM_V;
    LAS float* wsf = (LAS float*)(lds + 2 * SHM_V + 2 * SHM_K) + wid * 64; LAS float* li_l = wsf;
    float l_reg = 0; f32x16 o[2] = {}; bf16x8 qr[6];
    const int sr = tid >> 4, sc = (tid & 15) * 8, vr = tid >> 3, vc = (tid & 7) * 8, vst = v_st(vr, vc);
    const int vb0 = (int)(unsigned)(uintptr_t)V_lds + v_rd_base(lane);
    struct { bf16x8 vs, ks0, ks1; } sr_[2];
    unsigned kof = (unsigned)(sr * 256 + sc * 2), vof = (unsigned)(vr * 2048 + vc * 2);
    asm volatile("" : "+v"(kof), "+v"(vof));
#define SLOAD(i, k0) do { const char* kb_ = (const char*)Kh + (size_t)(k0) * 256; const char* vb_ = (const char*)Vh + (size_t)(k0) * 2048; \
    sr_[i].vs = *(const bf16x8*)(vb_ + vof); sr_[i].ks0 = *(const bf16x8*)(kb_ + kof); sr_[i].ks1 = *(const bf16x8*)(kb_ + kof + 8192u); } while (0)
#define SWRITE(b, i) do { *(LAS bf16x8*)(V_lds + (b) * SHM_V + vst) = sr_[i].vs; const int kc = sc * 2; \
    *(LAS bf16x8*)(K_lds + (b) * SHM_K + KSWZ(sr, kc)) = sr_[i].ks0; *(LAS bf16x8*)(K_lds + (b) * SHM_K + KSWZ(32 + sr, kc)) = sr_[i].ks1; } while (0)
#define SWAIT() asm volatile("s_waitcnt vmcnt(3)" ::: "memory")
    constexpr int SE = 0, SO = 1;
    SLOAD(SE, 0); SLOAD(SO, 64); SBAR();
    {
        const bf16_t* Qw = Qb + (size_t)(wid * 32 + r32) * 768 + hi * 8;
        float qf[6][8]; float rq; { const float* sa = rqrow + (size_t)(wid * 32 + r32) * 16; const f32x4 s1 = *(const f32x4*)(sa + 4), s2 = *(const f32x4*)(sa + 8), s3 = *(const f32x4*)(sa + 12);
            rq = 1.0f / sqrtf((((s1[1] + s1[2]) + (s1[3] + s2[0])) + ((s2[1] + s2[2]) + (s2[3] + s3[0])) + ((s3[1] + s3[2]) + s3[3])) * (1.0f / 256.0f) + EPS); }
        float ss = 0.f;
#pragma unroll
        for (int d0 = 0; d0 < 6; ++d0) { float f[8]; unpack8(*(const u32x4*)(Qw + d0 * 16), f);
#pragma unroll
            for (int e = 0; e < 8; ++e) { qf[d0][e] = f[e] * rq; ss += qf[d0][e] * qf[d0][e]; } }
        { auto rr = __builtin_amdgcn_permlane32_swap(__float_as_uint(ss), __float_as_uint(ss), false, false); ss = __uint_as_float(rr[0]) + __uint_as_float(rr[1]); }
        const float rn = QSCALE / sqrtf(ss * (1.0f / 96.0f) + EPS);
#pragma unroll
        for (int d0 = 0; d0 < 6; ++d0)
#pragma unroll
            for (int e = 0; e < 8; ++e) qf[d0][e] *= rn * qgain[d0 * 16 + hi * 8 + e];
        if (qpos >= 0) { const float* rc = rope_cs + (size_t)(qpos + wid * 32 + r32) * 16 + hi * 8;
#pragma unroll
            for (int e = 0; e < 8; ++e) { const float c = rc[e], sn = rc[32768 + e], r1 = qf[4][e], r2 = qf[5][e]; qf[4][e] = r1 * c - r2 * sn; qf[5][e] = r1 * sn + r2 * c; } }
#pragma unroll
        for (int d0 = 0; d0 < 6; ++d0) { u32x4 w; w.x = pk2(qf[d0][0], qf[d0][1]); w.y = pk2(qf[d0][2], qf[d0][3]); w.z = pk2(qf[d0][4], qf[d0][5]); w.w = pk2(qf[d0][6], qf[d0][7]); qr[d0] = __builtin_bit_cast(bf16x8, w); }
    }
    f32x16 pA0, pA1, pB0, pB1; bf16x8 pa0, pa1, pa2, pa3; const int NT = seq / 64;
    SBAR(); asm volatile("s_waitcnt vmcnt(0)" ::: "memory"); SWRITE(0, SE); SWRITE(1, SO);
    SLOAD(SE, (2 < NT ? 2 : NT - 1) * 64); __syncthreads();
    if (__builtin_amdgcn_readfirstlane(wid) >= 4) __builtin_amdgcn_s_setprio(1);
    qkt(pA0, pA1, K_lds, qr, r32, hi, negc); expA(pA0);
    for (int j = 1; j + 1 < NT; j += 2) {
        SBAR(); qkt(pB0, pB1, K_lds + SHM_K, qr, r32, hi, negc);
        finishSM(pA0, pA1, l_reg, pa0, pa1, pa2, pa3); SBAR();
        SLOAD(SO, (j + 2) * 64); SBAR();
        pv_one<0>(o[0], vb0, pa0, pa1, pa2, pa3); pv_one<1>(o[1], vb0, pa0, pa1, pa2, pa3); expA(pB0);
        __syncthreads(); SWAIT(); SWRITE(0, SE);
        __syncthreads();
        SBAR(); qkt(pA0, pA1, K_lds, qr, r32, hi, negc);
        finishSM(pB0, pB1, l_reg, pa0, pa1, pa2, pa3); SBAR();
        SLOAD(SE, (j + 3 < NT ? j + 3 : NT - 1) * 64); SBAR();
        pv_one<0>(o[0], vb0 + SHM_V, pa0, pa1, pa2, pa3); pv_one<1>(o[1], vb0 + SHM_V, pa0, pa1, pa2, pa3); expA(pA0);
        __syncthreads(); SWAIT(); SWRITE(1, SO);
        __syncthreads();
    }
    SBAR(); qkt(pB0, pB1, K_lds + SHM_K, qr, r32, hi, negc);
    finishSM(pA0, pA1, l_reg, pa0, pa1, pa2, pa3); SBAR();
    pv_one<0>(o[0], vb0, pa0, pa1, pa2, pa3); pv_one<1>(o[1], vb0, pa0, pa1, pa2, pa3); expA(pB0);
    __syncthreads();
    finishSM(pB0, pB1, l_reg, pa0, pa1, pa2, pa3); SBAR();
    pv_one<0>(o[0], vb0 + SHM_V, pa0, pa1, pa2, pa3); pv_one<1>(o[1], vb0 + SHM_V, pa0, pa1, pa2, pa3);
    if (hi == 0) li_l[r32] = l_reg; asm volatile("s_waitcnt lgkmcnt(0)" ::: "memory");
    float rli[16];
#pragma unroll
    for (int r = 0; r < 16; ++r) rli[r] = __builtin_amdgcn_rcpf(li_l[crow(r, hi)]);
    __builtin_amdgcn_s_setprio(0);
    unsigned char* Ow = Ob + (size_t)(wid * 32) * 2048 + (r32 & ~3);
    const int q4 = r32 & 3;
    const unsigned sel1 = (q4 & 1) ? 0x03070105u : 0x06020400u, sel2 = (q4 & 2) ? 0x03020706u : 0x05040100u;
#pragma unroll
    for (int d0 = 0; d0 < 2; ++d0)
#pragma unroll
        for (int i = 0; i < 4; ++i) {
            const unsigned w = pk4_fp8(o[d0][4 * i] * rli[4 * i], o[d0][4 * i + 1] * rli[4 * i + 1], o[d0][4 * i + 2] * rli[4 * i + 2], o[d0][4 * i + 3] * rli[4 * i + 3]);
            const unsigned p1 = (unsigned)__builtin_amdgcn_update_dpp(0, (int)w, 0xB1, 0xf, 0xf, false);
            const unsigned t1 = __builtin_amdgcn_perm(p1, w, sel1);
            const unsigned p2 = (unsigned)__builtin_amdgcn_update_dpp(0, (int)t1, 0x4E, 0xf, 0xf, false);
            const unsigned t2 = __builtin_amdgcn_perm(p2, t1, sel2);
            *(unsigned*)(Ow + (size_t)(q4 + 8 * i + 4 * hi) * 2048 + d0 * 32) = t2; }
#undef SLOAD
#undef SWRITE
#undef SWAIT
}
}
__device__ __forceinline__ void phase_attn(const Ctx& C, int layer, int half, bool do_ctx) {
    float gq = 0.f, gk = 0.f; { const float* qng = C.in(I_QNG) + layer * 96; const float* kng = C.in(I_KNG) + layer * 96; for (int e = 0; e < 96; ++e) { gq = fmaxf(gq, fabsf(qng[e])); gk = fmaxf(gk, fabsf(kng[e])); } }
    const float negc = -fminf(96.0f * gq * gk * QSCALE * 1.0001f, 60.0f);
    const unsigned char* mix = C.ws + WS_MIX;
    const bf16_t* QR = (const bf16_t*)(mix + MIX_QRAW); const float* RQ = (const float*)(mix + MIX_Q);        const bf16_t* K = (const bf16_t*)(mix + MIX_K); const bf16_t* KVR = (const bf16_t*)(mix + MIX_KVRAW); unsigned char* BR = C.ws + WS_BR;
    const float* qng = C.in(I_QNG) + layer * 96; const float* RC = (const float*)(C.ws + WS_ROPE);
    const int vcu = (C.G % 8 == 0) ? (C.bid % 8) * (C.G / 8) + C.bid / 8 : C.bid;
    const int nlat = 8 * NH * 8, nunits = nlat + (do_ctx ? 8 * NH : 0);
    for (int u = vcu; u < nunits; u += C.G) {
        int bh, t0, seq;
        if (u < nlat) { bh = u >> 3; t0 = CTX + (u & 7) * 256; seq = TPB; } else { bh = u - nlat; t0 = 0; seq = CTX; }
        const int bl = bh >> 3, h = bh & 7;
        __syncthreads();
        att::attn_body(QR + ((size_t)bl * TPB + t0) * 768 + h * 96, K + (size_t)bh * TPB * 128, KVR + (size_t)bl * TPB * 1024 + h * 128 + 64,
                       BR + ((size_t)(half * HROWS + bl * TPB + t0)) * 2048 + h * 64, seq, C.lds, C.tid, negc, RQ + ((size_t)half * HROWS + (size_t)bl * TPB + t0) * 16, qng, RC, t0 >= CTX ? t0 - CTX : -1);
    }
}

struct SchedQKV {
    static constexpr bool GATHER = false, FP8 = false;
    const char* P; const char* WUQ; const char* WUKV; int G, c;
    __device__ __forceinline__ bool next(int i, Unit& u) const { const int L = i * G + c; if (L >= HPAN * 7) return false; u.pm = L / 7; const int j = L - u.pm * 7; u.aux = (j + 5) >> 3; u.pn = j - 3 * u.aux; return true; }
    __device__ __forceinline__ void setup(const Unit& u, const char*& a, const char*& b0, const char*& b1, unsigned& lda, unsigned& ldb, int& nt, int& nt0) const {
        a = P + (size_t)u.pm * 256 * (PLD * 2) + (u.aux ? 0 : 320); b0 = (u.aux ? WUKV : WUQ) + (size_t)u.pn * 256 * 512; b1 = b0; lda = PLD * 2; ldb = 512u; nt = 4 - 2 * u.aux; nt0 = nt; }
    __device__ __forceinline__ unsigned rowoff(const Unit&, int) const { return 0u; }
    __device__ __forceinline__ bool keep_acc(const Unit&) const { return false; }
};
struct EpiQKV {
    static constexpr bool PERM = true;
    bf16_t* QR; bf16_t* KVR; bf16_t* Ko; const bf16_t* Pg; const float* SA; const float* kng; const float* RC;
    __device__ __forceinline__ void operator()(f32x4 (&acc)[2][2][4][2], const Unit& u, int wr, int wc, int fr, int fq) const {
        if (!u.aux) {
            const int row0 = u.pm * 256 + wr * 64 + fr, col0 = u.pn * 256 + wc * 32 + 8 * fq;
#pragma unroll
            for (int ai = 0; ai < 2; ++ai)
#pragma unroll
                for (int m = 0; m < 4; ++m) { bf16_t* rowp = QR + (size_t)(row0 + ai * 128 + m * 16) * 768 + col0;
#pragma unroll
                    for (int bj = 0; bj < 2; ++bj) { const f32x4 v0 = acc[ai][bj][m][0], v1 = acc[ai][bj][m][1];
                        u32x4 w; w.x = pk2(v0[0], v0[1]); w.y = pk2(v0[2], v0[3]); w.z = pk2(v1[0], v1[1]); w.w = pk2(v1[2], v1[3]);
                        *(u32x4*)(rowp + bj * 128) = w; } }
            return;
        }
        const int h = 2 * u.pn + (wc >> 1), ln = fq * 16 + fr; const bool isv = (wc & 1) != 0;
        const int row0 = u.pm * 256 + wr * 64 + fr;
        if (isv) {
#pragma unroll
            for (int ai = 0; ai < 2; ++ai) { f32x4 st[4];
#pragma unroll
                for (int m = 0; m < 4; ++m) st[m] = *(const f32x4*)(SA + (size_t)(row0 + ai * 128 + m * 16) * 16);
#pragma unroll
                for (int m = 0; m < 4; ++m) { const int lr = row0 + ai * 128 + m * 16; const float rkv = 1.0f / sqrtf(((st[m][0] + st[m][1]) + (st[m][2] + st[m][3])) * (1.0f / 128.0f) + EPS);
                    bf16_t* vp = KVR + (size_t)lr * 1024 + h * 128 + 64 + 8 * fq;
#pragma unroll
                    for (int bj = 0; bj < 2; ++bj) { const f32x4 v0 = acc[ai][bj][m][0] * rkv, v1 = acc[ai][bj][m][1] * rkv;
                        u32x4 w; w.x = pk2(v0[0], v0[1]); w.y = pk2(v0[2], v0[3]); w.z = pk2(v1[0], v1[1]); w.w = pk2(v1[2], v1[3]);
                        *(u32x4*)(vp + bj * 32) = w; } } }
            return;
        }
        float gn[2][8]; f32x4 gr1 = *(const f32x4*)(kng + 64 + 4 * fq), gr2 = *(const f32x4*)(kng + 80 + 4 * fq);
#pragma unroll
        for (int bj = 0; bj < 2; ++bj) { const f32x4 a = *(const f32x4*)(kng + bj * 32 + 8 * fq), b2 = *(const f32x4*)(kng + bj * 32 + 8 * fq + 4);
            gn[bj][0] = a[0]; gn[bj][1] = a[1]; gn[bj][2] = a[2]; gn[bj][3] = a[3]; gn[bj][4] = b2[0]; gn[bj][5] = b2[1]; gn[bj][6] = b2[2]; gn[bj][7] = b2[3]; }
#pragma unroll
        for (int aim = 0; aim < 4; ++aim) { const int ai = aim >> 1, m0 = (aim & 1) * 2;
            f32x4 st[4], cs[4], sn[4]; float kr2[4]; u32x2 ka[4], kb[4];
#pragma unroll
            for (int m = m0; m < m0 + 2; ++m) { const int lr = row0 + ai * 128 + m * 16; const int bl = lr / TPB, tt = lr - bl * TPB; const int pos = tt >= CTX ? tt - CTX : 0;
                st[m] = *(const f32x4*)(SA + (size_t)lr * 16); kr2[m] = SA[(size_t)lr * 16 + 4];
                ka[m] = *(const u32x2*)(Pg + (size_t)lr * PLD + 128 + 4 * fq); kb[m] = *(const u32x2*)(Pg + (size_t)lr * PLD + 144 + 4 * fq);
                cs[m] = *(const f32x4*)(RC + pos * 16 + 4 * fq); sn[m] = *(const f32x4*)(RC + 32768 + pos * 16 + 4 * fq); }
#pragma unroll
            for (int m = m0; m < m0 + 2; ++m) { const int lr = row0 + ai * 128 + m * 16; const int bl = lr / TPB, tt = lr - bl * TPB; const bool lat = tt >= CTX;
                const float rkv = 1.0f / sqrtf(((st[m][0] + st[m][1]) + (st[m][2] + st[m][3])) * (1.0f / 128.0f) + EPS);
                float x[2][8], ssq = 0.f;
#pragma unroll
                for (int bj = 0; bj < 2; ++bj)
#pragma unroll
                    for (int e = 0; e < 4; ++e) { x[bj][e] = acc[ai][bj][m][0][e] * rkv; x[bj][4 + e] = acc[ai][bj][m][1][e] * rkv; ssq += x[bj][e] * x[bj][e] + x[bj][4 + e] * x[bj][4 + e]; }
                ssq += shx(ssq, 16, ln); ssq += shx(ssq, 32, ln);
                const float rn = 1.0f / sqrtf((ssq + kr2[m]) * (1.0f / 96.0f) + EPS);
                bf16_t* kd = Ko + (((size_t)bl * NH + h) * TPB + tt) * 128;
#pragma unroll
                for (int bj = 0; bj < 2; ++bj) { u32x4 w; w.x = pk2(x[bj][0] * rn * gn[bj][0], x[bj][1] * rn * gn[bj][1]); w.y = pk2(x[bj][2] * rn * gn[bj][2], x[bj][3] * rn * gn[bj][3]);
                    w.z = pk2(x[bj][4] * rn * gn[bj][4], x[bj][5] * rn * gn[bj][5]); w.w = pk2(x[bj][6] * rn * gn[bj][6], x[bj][7] * rn * gn[bj][7]);
                    *(u32x4*)(kd + bj * 32 + 8 * fq) = w; }
                float r1[4] = {bflo(ka[m].x) * rn * gr1[0], bfhi(ka[m].x) * rn * gr1[1], bflo(ka[m].y) * rn * gr1[2], bfhi(ka[m].y) * rn * gr1[3]};
                float r2[4] = {bflo(kb[m].x) * rn * gr2[0], bfhi(kb[m].x) * rn * gr2[1], bflo(kb[m].y) * rn * gr2[2], bfhi(kb[m].y) * rn * gr2[3]};
                float o1[4], o2[4];
#pragma unroll
                for (int i = 0; i < 4; ++i) { o1[i] = lat ? r1[i] * cs[m][i] - r2[i] * sn[m][i] : r1[i]; o2[i] = lat ? r1[i] * sn[m][i] + r2[i] * cs[m][i] : r2[i]; }
                u32x2 w1, w2; w1.x = pk2(o1[0], o1[1]); w1.y = pk2(o1[2], o1[3]); w2.x = pk2(o2[0], o2[1]); w2.y = pk2(o2[2], o2[3]);
                *(u32x2*)(kd + 64 + 4 * fq) = w1; *(u32x2*)(kd + 80 + 4 * fq) = w2; }
        }
    }
};
struct EpiGate8 {
    static constexpr bool PERM = true;
    static constexpr float ACC0 = -7.994353436858858f; static constexpr bool PERM16 = true;
    unsigned char* S8a; unsigned char* S8b;
    __device__ __forceinline__ void operator()(f32x4 (&acc)[2][2][4][2], const Unit& u, int wr, int wc, int fr, int fq) const {
        const int row0 = u.pm * 256 + wr * 64 + fr, col0 = u.pn * 256 + wc * 64 + 16 * fq; unsigned char* S8 = u.pm < HPAN ? S8a : S8b;
#pragma unroll
        for (int ai = 0; ai < 2; ++ai)
#pragma unroll
            for (int m = 0; m < 4; ++m) { unsigned char* rowp = S8 + (size_t)(row0 + ai * 128 + m * 16) * 4096 + col0;
                u32x4 w = {0u, 0u, 0u, 0u};
#pragma unroll
                for (int bj = 0; bj < 2; ++bj)
#pragma unroll
                    for (int e = 0; e < 4; ++e) {
                        const float g0 = fmaxf(__builtin_amdgcn_rcpf(__builtin_amdgcn_exp2f(acc[ai][bj][m][0][e]) + (1.0f / 255.0f)) + 0.5f, 1.0f);
                        const float g1 = fmaxf(__builtin_amdgcn_rcpf(__builtin_amdgcn_exp2f(acc[ai][bj][m][1][e]) + (1.0f / 255.0f)) + 0.5f, 1.0f);
                        if (bj == 0) { w.x = __builtin_amdgcn_cvt_pk_u8_f32(g0, e, w.x); w.y = __builtin_amdgcn_cvt_pk_u8_f32(g1, e, w.y); }
                        else { w.z = __builtin_amdgcn_cvt_pk_u8_f32(g0, e, w.z); w.w = __builtin_amdgcn_cvt_pk_u8_f32(g1, e, w.w); } }
                *(u32x4*)rowp = w; }
    }
};
struct SchedP5 {
    static constexpr bool GATHER = false, FP8 = true;
    const char* BRp; const char* WB; int G, c, latent_only;
    __device__ __forceinline__ bool next(int i, Unit& u) const {
        if (i < 8) { u.aux = i & 3; if (!latent_only) return pg::grid_tile((long)(i >> 2) * G + c, NPAN, 4, u.pm, u.pn);
            const bool ok = pg::grid_tile((long)(i >> 2) * G + c, 128, 4, u.pm, u.pn); u.pm = (u.pm >> 3) * 9 + 1 + (u.pm & 7); return ok; }
        if (i >= 9 || latent_only) return false;
        u.aux = 4 + (c & 3); return pg::grid_tile(512 + (c >> 2), NPAN, 4, u.pm, u.pn); }
    __device__ __forceinline__ void setup(const Unit& u, const char*& a, const char*& b0, const char*& b1, unsigned& lda, unsigned& ldb, int& nt, int& nt0) const {
        const int n = u.aux & 3; a = BRp + (size_t)u.pm * 256 * 2048 + n * 512; b0 = WB + ((size_t)n * 1024 + u.pn * 256) * 512; nt = 4; lda = 2048u; ldb = 512u; b1 = b0; nt0 = nt; }
    __device__ __forceinline__ unsigned rowoff(const Unit&, int) const { return 0u; }
    __device__ __forceinline__ bool keep_acc(const Unit& u) const { return u.aux >= 1 && u.aux < 4; }
};
__device__ __forceinline__ void dec8(const u32x2 w, float (&f)[8]) {
    f[0] = (float)(w.x & 0xffu); f[1] = (float)((w.x >> 8) & 0xffu); f[2] = (float)((w.x >> 16) & 0xffu); f[3] = (float)(w.x >> 24);
    f[4] = (float)(w.y & 0xffu); f[5] = (float)((w.y >> 8) & 0xffu); f[6] = (float)((w.y >> 16) & 0xffu); f[7] = (float)(w.y >> 24); }
struct EpiP5 {
    static constexpr bool PERM = true, PERM16 = true;
    const unsigned char* S8a; const unsigned char* S8b;
    bf16_t* merged;
    unsigned char* part;
    __device__ __forceinline__ void operator()(f32x4 (&acc)[2][2][4][2], const Unit& u, int wr, int wc, int fr, int fq) const {
        const int n = u.aux & 3;
        const __amdgpu_buffer_rsrc_t rs = __builtin_amdgcn_make_buffer_rsrc((void*)(u.pm < HPAN ? S8a : S8b), 0, 0x7fffffff, 0x00020000);
        unsigned vo = (unsigned)(u.pm * 256 + wr * 64 + fr) * 4096u + (unsigned)(n * 1024 + u.pn * 256 + wc * 64 + 16 * fq); asm volatile("" : "+v"(vo));
        if (u.aux < 3) {
            u32x4 wa4[2][4], wb4[2][4];
#pragma unroll
            for (int ai = 0; ai < 2; ++ai)
#pragma unroll
                for (int m = 0; m < 4; ++m) { const int off = (ai * 128 + m * 16) * 4096;
                    wa4[ai][m] = __builtin_bit_cast(u32x4, __builtin_amdgcn_raw_buffer_load_b128(rs, (int)vo, off, 0));
                    wb4[ai][m] = __builtin_bit_cast(u32x4, __builtin_amdgcn_raw_buffer_load_b128(rs, (int)vo, off + 1024, 0)); }
#pragma unroll
            for (int ai = 0; ai < 2; ++ai)
#pragma unroll
                for (int bj = 0; bj < 2; ++bj)
#pragma unroll
                    for (int m = 0; m < 4; ++m) { float a[8], b[8]; dec8((u32x2){wa4[ai][m][2 * bj], wa4[ai][m][2 * bj + 1]}, a); dec8((u32x2){wb4[ai][m][2 * bj], wb4[ai][m][2 * bj + 1]}, b);
#pragma unroll
                        for (int e = 0; e < 4; ++e) { acc[ai][bj][m][0][e] *= a[e] * __builtin_amdgcn_rcpf(b[e]); acc[ai][bj][m][1][e] *= a[4 + e] * __builtin_amdgcn_rcpf(b[4 + e]); } }
        } else {
            const bool quarter = u.aux >= 4;
            unsigned lo = threadIdx.x * 16u; asm volatile("" : "+v"(lo));
            const int row0 = u.pm * 256 + wr * 64 + fr, col0 = u.pn * 256 + wc * 64 + 16 * fq;
            u32x4 w34[2][4];
#pragma unroll
            for (int ai = 0; ai < 2; ++ai)
#pragma unroll
                for (int m = 0; m < 4; ++m) w34[ai][m] = __builtin_bit_cast(u32x4, __builtin_amdgcn_raw_buffer_load_b128(rs, (int)vo, (ai * 128 + m * 16) * 4096, 0));
#pragma unroll
            for (int ai = 0; ai < 2; ++ai)
#pragma unroll
                for (int m = 0; m < 4; ++m)
#pragma unroll
                    for (int bj = 0; bj < 2; ++bj) { float a[8]; dec8((u32x2){w34[ai][m][2 * bj], w34[ai][m][2 * bj + 1]}, a);
                        const f32x4 v0 = acc[ai][bj][m][0] * (1.0f / 255.0f), v1 = acc[ai][bj][m][1] * (1.0f / 255.0f);
                        u32x4 w; w.x = pk2(v0[0] * a[0], v0[1] * a[1]); w.y = pk2(v0[2] * a[2], v0[3] * a[3]); w.z = pk2(v1[0] * a[4], v1[1] * a[5]); w.w = pk2(v1[2] * a[6], v1[3] * a[7]);
                        if (quarter) *(u32x4*)(part + ((ai * 2 + bj) * 4 + m) * 8192 + lo) = w;
                        else *(u32x4*)(merged + (size_t)(row0 + ai * 128 + m * 16) * DM + col0 + bj * 8) = w; }
        }
    }
};

struct EpiP6 {
    static constexpr bool PERM = true;
    const float* xin; const float* cin;
    const bf16_t* XB; bf16_t* XD; const float* MODL; float* ST;
    __device__ __forceinline__ void operator()(f32x4 (&acc)[2][2][4][2], const pg::Unit& u, int wr, int wc, int fr, int fq) const {
        const int row0 = u.pm * 256 + wr * 64 + fr, col0 = u.pn * 256 + wc * 32 + 8 * fq, ln = fq * 16 + fr;
        const float* gate = MODL + (size_t)mod_index(u.pm * 256) * 6144 + 2 * DM + col0;
        const f32x4 g00 = *(const f32x4*)gate, g01 = *(const f32x4*)(gate + 4), g10 = *(const f32x4*)(gate + 128), g11 = *(const f32x4*)(gate + 132);
#pragma unroll
        for (int ai = 0; ai < 2; ++ai) {
            float xv[4][2][8];
            if (xin) {
#pragma unroll
                for (int m = 0; m < 4; ++m) { const float* xr = xrow_c(xin, cin, row0 + ai * 128 + m * 16) + col0;
#pragma unroll
                    for (int bj = 0; bj < 2; ++bj) { const f32x4 a = *(const f32x4*)(xr + bj * 128), b = *(const f32x4*)(xr + bj * 128 + 4);
                        xv[m][bj][0] = a[0]; xv[m][bj][1] = a[1]; xv[m][bj][2] = a[2]; xv[m][bj][3] = a[3]; xv[m][bj][4] = b[0]; xv[m][bj][5] = b[1]; xv[m][bj][6] = b[2]; xv[m][bj][7] = b[3]; } }
            } else { u32x4 raw[4][2];
#pragma unroll
                for (int m = 0; m < 4; ++m)
#pragma unroll
                    for (int bj = 0; bj < 2; ++bj) raw[m][bj] = *(const u32x4*)(XB + (size_t)(row0 + ai * 128 + m * 16) * DM + col0 + bj * 128);
#pragma unroll
                for (int m = 0; m < 4; ++m)
#pragma unroll
                    for (int bj = 0; bj < 2; ++bj) unpack8(raw[m][bj], xv[m][bj]); }
#pragma unroll
            for (int m = 0; m < 4; ++m) { const int row = row0 + ai * 128 + m * 16; float ssq = 0.f;
#pragma unroll
                for (int bj = 0; bj < 2; ++bj) { const f32x4 ga = bj ? g10 : g00, gb = bj ? g11 : g01; float v[8];
#pragma unroll
                    for (int e = 0; e < 4; ++e) { v[e] = xv[m][bj][e] + ga[e] * acc[ai][bj][m][0][e]; v[4 + e] = xv[m][bj][4 + e] + gb[e] * acc[ai][bj][m][1][e]; ssq += v[e] * v[e] + v[4 + e] * v[4 + e]; }
                    u32x4 w; w.x = pk2(v[0], v[1]); w.y = pk2(v[2], v[3]); w.z = pk2(v[4], v[5]); w.w = pk2(v[6], v[7]);
                    *(u32x4*)(XD + (size_t)row * DM + col0 + bj * 128) = w; }
                ssq += shx(ssq, 16, ln); ssq += shx(ssq, 32, ln);
                if (fq == 0) ST[(size_t)row * 16 + u.pn * 4 + wc] = ssq; }
        }
    }
};
struct Norm2Raw { u32x4 a0, a1; f32x4 s0, s1, s2, s3; };
__device__ __forceinline__ void phase_norm2_router(const Ctx& C, int layer, const bf16_t* XN) {
    const float* ST = (const float*)(C.ws + WS_MIX + MIX_OUT);
    const float* g = C.in(I_N2G) + layer * DM; const float* MOD = (const float*)(C.ws + WS_MOD) + (size_t)layer * MODLD; bf16_t* H = (bf16_t*)(C.ws + WS_H);
    const float* rw = C.in(I_RW); const float* rb = C.in(I_RB);
    int* CLS = (int*)(C.ws + WS_MIX + MOE_CLS); f32x2* WTS = (f32x2*)(C.ws + WS_MIX + MOE_WTS); int* BLK = (int*)(C.ws + WS_MIX + MOE_BLK);
    constexpr int HLD = 1028;
    LAS float* HB = (LAS float*)C.lds;
    LAS float* PB = (LAS float*)(C.lds + 65792);
    LAS float* LG = (LAS float*)(C.lds + 65792 + 8192);
    LAS int* hist = (LAS int*)(C.lds + 65792 + 8192 + 9216);
    const int rows_per = NTOK / C.G;
    const int fe = C.lane & 15, fk = C.lane >> 4;
    float Bw[32];
#pragma unroll
    for (int sj = 0; sj < 32; ++sj) Bw[sj] = rw[(size_t)(C.wave * 128 + (sj >> 2) * 16 + fk * 4 + (sj & 3)) * 16 + fe];
    if (C.tid < 32) hist[C.tid] = 0;
    const int rbase = C.bid * rows_per + 2 * C.wave;
    const bool skip_all = false; (void)skip_all;
    Norm2Raw RA0, RA1, RB0, RB1;
#define P7_SKIP(r) (layer == DEPTH - 1 && ((r) % TPB) < CTX)
#define P7_LOAD(R, r) do { const bf16_t* xp_ = XN + (size_t)(r) * DM + 8 * C.lane; R.a0 = *(const u32x4*)xp_; R.a1 = *(const u32x4*)(xp_ + 512); const float* sp_ = ST + (size_t)(r) * 16;        \
        R.s0 = *(const f32x4*)sp_; R.s1 = *(const f32x4*)(sp_ + 4); R.s2 = *(const f32x4*)(sp_ + 8); R.s3 = *(const f32x4*)(sp_ + 12); } while (0)
    int mi_cur = -1; float Av[16], Sv[16];
#define P7_MOD(r) do { const int mi_ = mod_index(r); if (mi_ != mi_cur) { mi_cur = mi_; const float* m_ = MOD + (size_t)mi_ * 6144; \
        _Pragma("unroll") for (int q = 0; q < 4; ++q) { const int c_ = (q >> 1) * 512 + 8 * C.lane + (q & 1) * 4; const f32x4 gg = *(const f32x4*)(g + c_), sh = *(const f32x4*)(m_ + 3 * DM + c_), sc = *(const f32x4*)(m_ + 4 * DM + c_); \
            _Pragma("unroll") for (int j = 0; j < 4; ++j) { Av[q * 4 + j] = gg[j] * (1.0f + sc[j]); Sv[q * 4 + j] = sh[j]; } } } } while (0)
#define P7_ROW(R, r, slot) do { LAS float* hb = HB + (slot) * HLD + 8 * C.lane; float h[16]; \
        if (!P7_SKIP(r)) { P7_MOD(r); float v_[16]; { float t_[8]; unpack8(R.a0, t_); _Pragma("unroll") for (int j = 0; j < 8; ++j) v_[j] = t_[j]; unpack8(R.a1, t_); _Pragma("unroll") for (int j = 0; j < 8; ++j) v_[8 + j] = t_[j]; } \
            const f32x4 sq_ = (R.s0 + R.s1) + (R.s2 + R.s3); const float rstd_ = 1.0f / sqrtf(((sq_[0] + sq_[1]) + (sq_[2] + sq_[3])) * (1.0f / 1024.0f) + EPS); \
            _Pragma("unroll") for (int j = 0; j < 16; ++j) h[j] = v_[j] * rstd_ * Av[j] + Sv[j]; \
            store_h_wt(H + (size_t)(r) * DM, C.lane, h); } \
        else { float zf = 0.f; asm volatile("" : "+v"(zf)); _Pragma("unroll") for (int j = 0; j < 16; ++j) h[j] = zf; } \
        *(LAS f32x4*)hb = (f32x4){h[0], h[1], h[2], h[3]}; *(LAS f32x4*)(hb + 4) = (f32x4){h[4], h[5], h[6], h[7]}; *(LAS f32x4*)(hb + 512) = (f32x4){h[8], h[9], h[10], h[11]}; *(LAS f32x4*)(hb + 516) = (f32x4){h[12], h[13], h[14], h[15]}; } while (0)
    P7_LOAD(RA0, rbase); P7_LOAD(RA1, rbase + 1); P7_LOAD(RB0, rbase + 16); P7_LOAD(RB1, rbase + 17);
#define P7_ROUND(rd, RX0, RX1) do { const int r = rbase + (rd) * 16; \
        P7_ROW(RX0, r, 2 * C.wave); P7_ROW(RX1, r + 1, 2 * C.wave + 1); \
        if ((rd) + 2 < rows_per / 16) { P7_LOAD(RX0, r + 32); P7_LOAD(RX1, r + 33); }        \
        __syncthreads(); \
        { f32x4 acc0 = {0.f, 0.f, 0.f, 0.f}, acc1 = {0.f, 0.f, 0.f, 0.f}; const LAS float* ap = HB + fe * HLD + C.wave * 128 + fk * 4;        \
          _Pragma("unroll") for (int st = 0; st < 8; st += 2) { const f32x4 av = *(const LAS f32x4*)(ap + st * 16), aw = *(const LAS f32x4*)(ap + st * 16 + 16); \
              _Pragma("unroll") for (int j = 0; j < 4; ++j) { acc0 = __builtin_amdgcn_mfma_f32_16x16x4f32(av[j], Bw[st * 4 + j], acc0, 0, 0, 0); acc1 = __builtin_amdgcn_mfma_f32_16x16x4f32(aw[j], Bw[st * 4 + 4 + j], acc1, 0, 0, 0); } } \
          LAS float* pp = PB + C.wave * 256 + (fk * 4) * 16 + fe; \
          _Pragma("unroll") for (int j = 0; j < 4; ++j) pp[j * 16] = acc0[j] + acc1[j]; } \
        __syncthreads(); \
        if (C.tid < 256) { float sum = 0.f; \
            _Pragma("unroll") for (int w = 0; w < 8; ++w) sum += PB[w * 256 + C.tid]; \
            LG[(rd) * 256 + C.tid] = sum; } } while (0)
    for (int rd = 0; rd + 1 < rows_per / 16; rd += 2) { P7_ROUND(rd, RA0, RA1); P7_ROUND(rd + 1, RB0, RB1); }
    P7_ROUND(rows_per / 16 - 1, RA0, RA1);
#undef P7_ROUND
#undef P7_LOAD
#undef P7_ROW
#undef P7_MOD
    __syncthreads();
    if (C.tid < rows_per) {
        const int r = C.bid * rows_per + C.tid;
        if (P7_SKIP(r)) CLS[r] = -1;
        else {
        float lg[16];
#pragma unroll
        for (int q = 0; q < 4; ++q) { const f32x4 t = *(const LAS f32x4*)(LG + C.tid * 16 + q * 4); lg[q * 4] = t[0]; lg[q * 4 + 1] = t[1]; lg[q * 4 + 2] = t[2]; lg[q * 4 + 3] = t[3]; }
        float s[16], sb[16];
#pragma unroll
        for (int e = 0; e < 16; ++e) { s[e] = 1.0f / (1.0f + expf(-lg[e])); sb[e] = s[e] + rb[e]; }
        int gsel = 0; float gbest = -1e30f;
#pragma unroll
        for (int gi = 0; gi < 4; ++gi) { const float a0 = sb[gi * 4], a1 = sb[gi * 4 + 1], a2 = sb[gi * 4 + 2], a3 = sb[gi * 4 + 3];
            const float mx = fmaxf(fmaxf(a0, a1), fmaxf(a2, a3));
            const float hi01 = fmaxf(a0, a1), lo01 = fminf(a0, a1), hi23 = fmaxf(a2, a3), lo23 = fminf(a2, a3);
            const float second = fmaxf(fminf(hi01, hi23), fmaxf(lo01, lo23));
            const float sc = mx + second;
            if (sc > gbest) { gbest = sc; gsel = gi; } }
        float v[4], sv[4];
#pragma unroll
        for (int j = 0; j < 4; ++j) { v[j] = gsel == 0 ? sb[j] : gsel == 1 ? sb[4 + j] : gsel == 2 ? sb[8 + j] : sb[12 + j]; sv[j] = gsel == 0 ? s[j] : gsel == 1 ? s[4 + j] : gsel == 2 ? s[8 + j] : s[12 + j]; }
        int i1 = 0; float m1 = v[0];
#pragma unroll
        for (int j = 1; j < 4; ++j) if (v[j] > m1) { i1 = j; m1 = v[j]; }
        int i2 = -1; float m2 = -1e30f;
#pragma unroll
        for (int j = 0; j < 4; ++j) if (j != i1 && v[j] > m2) { i2 = j; m2 = v[j]; }
        const int lo = i1 < i2 ? i1 : i2, hi = i1 < i2 ? i2 : i1;
        const float slo = lo == 0 ? sv[0] : (lo == 1 ? sv[1] : sv[2]), shi = hi == 1 ? sv[1] : (hi == 2 ? sv[2] : sv[3]), inv = 1.0f / (slo + shi);
        const int pair = lo == 0 ? hi - 1 : (lo == 1 ? hi + 1 : 5);
        const int cls = gsel * 6 + pair;
        CLS[r] = cls; WTS[r] = (f32x2){slo * inv, shi * inv}; __hip_atomic_fetch_add(hist + cls, 1, __ATOMIC_RELAXED, __HIP_MEMORY_SCOPE_WORKGROUP);
        }
    }
#undef P7_SKIP
    __syncthreads();
    if (C.tid < 32) BLK[C.bid * 32 + C.tid] = C.tid < 24 ? hist[C.tid] : 0;
}
__device__ __forceinline__ void class_experts(int cls, int& ea, int& eb) { const int g = cls / 6, p = cls - g * 6; const int lo = p < 3 ? 0 : (p < 5 ? 1 : 2); const int hi = p < 3 ? p + 1 : (p < 5 ? p - 1 : 3); ea = g * 4 + lo; eb = g * 4 + hi; }
__device__ __forceinline__ void phase_sort(const Ctx& C) {
    const int* CLS = (const int*)(C.ws + WS_MIX + MOE_CLS); const f32x2* WTS = (const f32x2*)(C.ws + WS_MIX + MOE_WTS); const int* BLK = (const int*)(C.ws + WS_MIX + MOE_BLK);
    int* TILE = (int*)(C.ws + WS_MIX + MOE_TILE); int* SIDX = (int*)(C.ws + WS_MIX + MOE_SIDX); f32x2* SW = (f32x2*)(C.ws + WS_MIX + MOE_SW);
    LAS int* tot = (LAS int*)C.lds; LAS int* pre = tot + 32; LAS int* base = tot + 64; LAS int* lcls = tot + 128;
    const int rows_per = NTOK / C.G;
    __syncthreads();
    for (int c = C.wave; c < 24; c += 8) { int t = 0, p = 0;
        for (int b = C.lane; b < C.G; b += 64) { const int v = BLK[b * 32 + c]; t += v; p += b < C.bid ? v : 0; }
        for (int o = 32; o >= 1; o >>= 1) { t += shxi(t, o, C.lane); p += shxi(p, o, C.lane); }
        if (C.lane == 0) { tot[c] = t; pre[c] = p; } }
    __syncthreads();
    if (C.tid == 0) { int acc = 0; for (int c = 0; c < 24; ++c) { base[c] = acc * 256; acc += (tot[c] + 255) >> 8; } base[24] = acc; }
    for (int i = C.tid; i < rows_per; i += 512) lcls[i] = CLS[C.bid * rows_per + i];
    __syncthreads();
    for (int i = C.tid; i < rows_per; i += 512) { const int c = lcls[i]; if (c < 0) continue; int rank = 0; for (int j = 0; j < i; ++j) rank += lcls[j] == c ? 1 : 0;
        const int pos = base[c] + pre[c] + rank, r = C.bid * rows_per + i; SIDX[pos] = r; SW[pos] = WTS[r]; }
    if (C.bid == 0) {
        if (C.tid == 0) TILE[0] = base[24];
        for (int c = C.wave; c < 24; c += 8) { const int nt = (tot[c] + 255) >> 8, t0 = base[c] >> 8;
            for (int j = C.lane; j < nt; j += 64) { TILE[8 + (t0 + j) * 2] = c; TILE[8 + (t0 + j) * 2 + 1] = min(256, tot[c] - j * 256); }
            for (int j = tot[c] + C.lane; j < nt * 256; j += 64) { float zf = 0.f; asm volatile("" : "+v"(zf)); SIDX[base[c] + j] = 0; SW[base[c] + j] = (f32x2){zf, zf}; } }
    }
}
struct SchedMoe1 {
    static constexpr bool GATHER = true, FP8 = false;
    const char* H; const char* W13; const int* TILE; const int* SIDX; int ntiles, G, c;
    __device__ __forceinline__ bool next(int i, Unit& u) const { const long L = (long)i * G + c; if (L >= (long)ntiles * 4) return false; u.aux = (int)(L >> 2); u.pn = (int)(L & 3); u.pm = __builtin_amdgcn_readfirstlane(ld_agent(TILE + 8 + u.aux * 2)); return true; }
    __device__ __forceinline__ void setup(const Unit& u, const char*& a, const char*& b0, const char*& b1, unsigned& lda, unsigned& ldb, int& nt, int& nt0) const {
        int ea, eb; class_experts(u.pm, ea, eb); const int e = u.pn < 2 ? ea : eb;
        a = H; b0 = W13 + ((size_t)e * 512 + (u.pn & 1) * 256) * 2048; b1 = b0; nt = 16; nt0 = 16; lda = 2048u; ldb = 2048u; }
    __device__ __forceinline__ unsigned rowoff(const Unit& u, int r) const { return (unsigned)SIDX[u.aux * 256 + r] * 2048u; }
    __device__ __forceinline__ bool keep_acc(const Unit&) const { return false; }
};
struct EpiMoe1 {
    static constexpr bool PERM = true, PERM16 = true;
    bf16_t* ACT; const int* TILE; const f32x2* SW;
    __device__ __forceinline__ void operator()(f32x4 (&acc)[2][2][4][2], const Unit& u, int wr, int wc, int fr, int fq) const {
        const int tile = u.aux, nrows = __builtin_amdgcn_readfirstlane(ld_agent(TILE + 8 + tile * 2 + 1)), sel = u.pn >> 1;
        const int ac0 = sel * 256 + (u.pn & 1) * 128 + wc * 32 + 8 * fq;
#pragma unroll
        for (int ai = 0; ai < 2; ++ai)
#pragma unroll
            for (int m = 0; m < 4; ++m) { const int r = ai * 128 + wr * 64 + m * 16 + fr; const size_t pos = (size_t)tile * 256 + r;
                const f32x2 ww = SW[pos]; const float w = r < nrows ? (sel ? ww.y : ww.x) : 0.f; u32x4 o;
#pragma unroll
                for (int bj = 0; bj < 2; ++bj) { const f32x4 v0 = acc[ai][bj][m][0], v1 = acc[ai][bj][m][1];
                    const float o0 = v0[0] * fast_sigmoid(v0[0]) * v0[1] * w, o1 = v0[2] * fast_sigmoid(v0[2]) * v0[3] * w, o2 = v1[0] * fast_sigmoid(v1[0]) * v1[1] * w, o3 = v1[2] * fast_sigmoid(v1[2]) * v1[3] * w;
                    if (bj == 0) { o.x = pk2(o0, o1); o.y = pk2(o2, o3); } else { o.z = pk2(o0, o1); o.w = pk2(o2, o3); } }
                *(u32x4*)(ACT + pos * 512 + ac0) = o; }
    }
};
struct SchedMoe2 {
    static constexpr bool GATHER = false, FP8 = false;
    const char* ACT; const char* W2; const int* TILE; int ntiles, G, c;
    __device__ __forceinline__ bool next(int i, Unit& u) const { const long L = (long)i * G + c; if (L >= (long)ntiles * 4) return false; u.aux = (int)(L >> 2); u.pn = (int)(L & 3); u.pm = __builtin_amdgcn_readfirstlane(ld_agent(TILE + 8 + u.aux * 2)); return true; }
    __device__ __forceinline__ void setup(const Unit& u, const char*& a, const char*& b0, const char*& b1, unsigned& lda, unsigned& ldb, int& nt, int& nt0) const {
        int ea, eb; class_experts(u.pm, ea, eb);
        a = ACT + (size_t)u.aux * 256 * 1024; b0 = W2 + ((size_t)ea * 1024 + u.pn * 256) * 512; b1 = W2 + ((size_t)eb * 1024 + u.pn * 256) * 512; nt = 8; nt0 = 4; lda = 1024u; ldb = 512u; }
    __device__ __forceinline__ unsigned rowoff(const Unit&, int) const { return 0u; }
    __device__ __forceinline__ bool keep_acc(const Unit&) const { return false; }
};
struct EpiMoe2 {
    static constexpr bool PERM = true;
    bf16_t* Y; const int* TILE; const int* SIDX; bf16_t* dummy;
    __device__ __forceinline__ void operator()(f32x4 (&acc)[2][2][4][2], const Unit& u, int wr, int wc, int fr, int fq) const {
        const int tile = u.aux, nrows = __builtin_amdgcn_readfirstlane(ld_agent(TILE + 8 + tile * 2 + 1)); const int col0 = u.pn * 256 + wc * 32 + 8 * fq;
#pragma unroll
        for (int ai = 0; ai < 2; ++ai)
#pragma unroll
            for (int m = 0; m < 4; ++m) { const int r = ai * 128 + wr * 64 + m * 16 + fr;
                const int tok = SIDX[tile * 256 + r]; bf16_t* yr = (r < nrows ? Y + (size_t)tok * DM : dummy) + col0;
#pragma unroll
                for (int bj = 0; bj < 2; ++bj) { const f32x4 v0 = acc[ai][bj][m][0], v1 = acc[ai][bj][m][1];
                    u32x4 w; w.x = pk2(v0[0], v0[1]); w.y = pk2(v0[2], v0[3]); w.z = pk2(v1[0], v1[1]); w.w = pk2(v1[2], v1[3]);
                    *(u32x4*)(yr + bj * 128) = w; } }
    }
};

constexpr int NPH_LAYER = 16, NPHASES = 1 + DEPTH * NPH_LAYER + 1;
#define EN(k) (((MASK) >> (k)) & 1)
#ifndef MK_DUP
#define MK_DUP 0
#endif
#define REP(k) for (int rep_ = 0; rep_ < (((MK_DUP) >> (k)) & 1) + 1; ++rep_)
template <int MASK>
__global__ void __launch_bounds__(512, 2) fwd(Args args) {
    extern __shared__ __attribute__((aligned(16))) unsigned char lds_raw[];
    Ctx C0; C0.kin = (const float* const __attribute__((address_space(4)))*)__builtin_amdgcn_kernarg_segment_ptr(); C0.ws = args.ws; C0.lds = (LAS unsigned char*)lds_raw; C0.tid = threadIdx.x; C0.lane = C0.tid & 63; C0.wave = __builtin_amdgcn_readfirstlane(C0.tid >> 6); C0.G = gridDim.x; C0.bid = blockIdx.x;
    volatile LAS unsigned* misc = (volatile LAS unsigned*)(C0.lds + LDS_MISC);
    if (C0.tid < 4) misc[C0.tid] = 0u;
    __syncthreads();
    const int lo = args.ph_lo, hi = args.ph_hi;
    XcdBarrier bar; bar.bar = (unsigned*)(C0.ws + WS_BAR); bar.x = 0; bar.st = misc;
    if (hi - lo > 1) bar = xcd_barrier_post((unsigned*)(C0.ws + WS_BAR), misc);
#define IN(k) (lo <= (k) && (k) < hi)
#ifndef MK_BAR2
#define MK_BAR2 0
#endif
#define SEAM(k) do { if (IN(k) && IN((k) + 1)) { xcd_barrier(bar); if (MK_BAR2) xcd_barrier(bar); } } while (0)
#define PHASE_CTX(P) Ctx P = C0; { int t_ = C0.tid; asm volatile("" : "+v"(t_)); P.tid = t_; P.lane = t_ & 63; P.wave = __builtin_amdgcn_readfirstlane(t_ >> 6); \
        unsigned long long w_ = (unsigned long long)C0.ws; asm volatile("" : "+s"(w_)); P.ws = (unsigned char*)(__attribute__((address_space(1))) unsigned char*)w_;        \
        unsigned long long k_ = (unsigned long long)C0.kin; asm volatile("" : "+s"(k_)); P.kin = (const float* const __attribute__((address_space(4)))*)k_; } \
        unsigned char* ws = P.ws; unsigned char* W = ws + WS_W; unsigned char* mix = ws + WS_MIX; float* xl = (float*)P.in(N_INPUTS); bf16_t* XB = (bf16_t*)xl; bf16_t* XB2 = (bf16_t*)(ws + WS_BR); (void)W; (void)mix; (void)xl; (void)XB; (void)XB2

    if (EN(15) && IN(0)) { { PHASE_CTX(C); phase_prologue(C); } { PHASE_CTX(C); __syncthreads(); phase_cvt(C, 0); } }
    SEAM(0);
    for (int layer = 0; layer < DEPTH; ++layer) {
        const int pb = 1 + layer * NPH_LAYER;
        if (EN(0) && IN(pb)) { PHASE_CTX(C); if (layer > 0) phase_cvt(C, layer); phase_norm1(C, layer, XB); }
        SEAM(pb);
        for (int st = 0; st < 5; ++st) {
            if (EN(4) && (st == 2 || st == 4)) { const int half = (st - 2) >> 1; { PHASE_CTX(C); phase_attn(C, layer, half, layer < DEPTH - 1); } __syncthreads(); }
            if (EN(1) && (st == 0 || st == 2)) { const int half = st >> 1;
                PHASE_CTX(C);
                pg::SchedGrid S; S.init(ws + WS_H + (size_t)half * HROWS * 2048, 2048, W + W_IN, 2048, 1024, HPAN, 14);
                pg::EpiP2 E{(bf16_t*)(mix + MIX_P), (float*)(ws + WS_SS), (float*)(mix + MIX_Q) + (size_t)half * HROWS * 16};
                pg::gemm_phase(C.lds, S, E);
            }
            if (EN(2) && (st == 1 || st == 3)) { const int half = (st - 1) >> 1;
                { PHASE_CTX(C); SchedQKV S{(const char*)(mix + MIX_P), (const char*)(W + W_UQ), (const char*)(W + W_UKV), C.G, C.bid}; EpiQKV E{(bf16_t*)(mix + MIX_QRAW), (bf16_t*)(mix + MIX_KVRAW), (bf16_t*)(mix + MIX_K), (const bf16_t*)(mix + MIX_P), (const float*)(mix + MIX_Q) + (size_t)half * HROWS * 16, C.in(I_KNG) + layer * 96, (const float*)(ws + WS_ROPE)}; pg::gemm_phase(C.lds, S, E); }
                { PHASE_CTX(C); phase_conv(C, layer, half); }
                { PHASE_CTX(C); phase_pool(C, half); }
                { PHASE_CTX(C); phase_sgu(C, layer, half); }
            }
            if (EN(6) && st == 4) {
                PHASE_CTX(C);
                pg::SchedGrid8 S; if (layer == DEPTH - 1) S.init(ws + WS_H8, 1024, W + W_G, 1024, 512, 128, 16, 1); else S.init(ws + WS_H8, 1024, W + W_G, 1024, 512, NPAN, 16);
                EpiGate8 E{mix + MIX_S8, ws + WS_BR};
                pg::gemm_phase(C.lds, S, E);
            }
            SEAM(pb);
        }
        if (EN(9) && IN(pb + 10)) REP(9) {
            PHASE_CTX(C);
            SchedP5 S{(const char*)(ws + WS_BR), (const char*)(W + W_B), C.G, C.bid, layer == DEPTH - 1};
            unsigned char* PART = mix + MOE_CLS;
            EpiP5 E{mix + MIX_S8, ws + WS_BR, (bf16_t*)(mix + MIX_MERGED), PART + (size_t)C.bid * 131072};
            pg::gemm_phase(C.lds, S, E);
            if (layer < DEPTH - 1) {
            asm volatile("s_waitcnt vmcnt(0)" ::: "memory"); __syncthreads();
            volatile LAS int* lastf = (volatile LAS int*)(C.lds + LDS_MISC + 64);
            if (C.tid == 0) {
                __builtin_amdgcn_fence(__ATOMIC_RELEASE, "agent"); asm volatile("s_waitcnt vmcnt(0)" ::: "memory");
                const unsigned old = __hip_atomic_fetch_add((unsigned*)(ws + WS_BAR + 16384) + 64 * (C.bid >> 2), 1u, __ATOMIC_RELAXED, __HIP_MEMORY_SCOPE_AGENT);
                const int last = (old & 3u) == 3u; *lastf = last;
                if (last) { __builtin_amdgcn_fence(__ATOMIC_ACQUIRE, "agent"); asm volatile("s_waitcnt vmcnt(0)" ::: "memory"); }
            }
            __syncthreads();
            if (*lastf) {
                int pm, pn; pg::grid_tile(512 + (C.bid >> 2), NPAN, 4, pm, pn);
                const int wid = C.tid >> 6, wr = wid >> 2, wc = wid & 3, fr = C.lane & 15, fq = C.lane >> 4;
                const unsigned char* p0 = PART + (size_t)(C.bid & ~3) * 131072 + C.tid * 16; bf16_t* MG = (bf16_t*)(mix + MIX_MERGED);
#pragma unroll 4
                for (int j = 0; j < 16; ++j) { const int ai = j >> 3, bj = (j >> 2) & 1, m = j & 3; float sum[8];
#pragma unroll
                    for (int e = 0; e < 8; ++e) sum[e] = 0.f;
#pragma unroll
                    for (int q = 0; q < 4; ++q) { float f[8]; unpack8(*(const u32x4*)(p0 + (size_t)q * 131072 + j * 8192), f);
#pragma unroll
                        for (int e = 0; e < 8; ++e) sum[e] += f[e]; }
                    u32x4 w; w.x = pk2(sum[0], sum[1]); w.y = pk2(sum[2], sum[3]); w.z = pk2(sum[4], sum[5]); w.w = pk2(sum[6], sum[7]);
                    *(u32x4*)(MG + (size_t)(pm * 256 + ai * 128 + wr * 64 + m * 16 + fr) * DM + pn * 256 + wc * 64 + 16 * fq + 8 * bj) = w; }
            }
            }
        }
        SEAM(pb + 10);
        if (EN(10) && IN(pb + 11)) REP(10) {
            PHASE_CTX(C);
            pg::SchedGrid S; if (layer == DEPTH - 1) S.init(mix + MIX_MERGED, 2048, W + W_O, 2048, 1024, 128, 4, 1); else S.init(mix + MIX_MERGED, 2048, W + W_O, 2048, 1024, NPAN, 4);
            EpiP6 E{layer == 0 ? C.in(I_X) : nullptr, C.in(I_CTX), XB, layer == DEPTH - 1 ? XB2 : XB, (const float*)(ws + WS_MOD) + (size_t)layer * MODLD, (float*)(mix + MIX_OUT)};
            pg::gemm_phase(C.lds, S, E);
        }
        SEAM(pb + 11);
        if (EN(11) && IN(pb + 12)) { PHASE_CTX(C); phase_norm2_router(C, layer, layer == DEPTH - 1 ? XB2 : XB); }
        SEAM(pb + 12);
        if (EN(12) && IN(pb + 13)) REP(12) { PHASE_CTX(C); phase_sort(C); }
        SEAM(pb + 13);
        if (EN(13) && IN(pb + 14)) REP(13) {
            PHASE_CTX(C);
            const int* TILE = (const int*)(mix + MOE_TILE);
            const int ntiles = min(__builtin_amdgcn_readfirstlane(ld_agent(TILE)), MAXT);
            const int vcu = (C.G % 8 == 0) ? (C.bid % 8) * (C.G / 8) + C.bid / 8 : C.bid;
            SchedMoe1 S{(const char*)(ws + WS_H), (const char*)(W + W_13), TILE, (const int*)(mix + MOE_SIDX), ntiles, C.G, vcu};
            EpiMoe1 E{(bf16_t*)(mix + MOE_ACT), TILE, (const f32x2*)(mix + MOE_SW)};
            pg::gemm_phase(C.lds, S, E);
        }
        SEAM(pb + 14);
        if (EN(14) && IN(pb + 15)) REP(14) {
            PHASE_CTX(C);
            const int* TILE = (const int*)(mix + MOE_TILE);
            const int ntiles = min(__builtin_amdgcn_readfirstlane(ld_agent(TILE)), MAXT);
            const int vcu = (C.G % 8 == 0) ? (C.bid % 8) * (C.G / 8) + C.bid / 8 : C.bid;
            SchedMoe2 S{(const char*)(mix + MOE_ACT), (const char*)(W + W_2), TILE, ntiles, C.G, vcu};
            EpiMoe2 E{(bf16_t*)(mix + MIX_OUT), TILE, (const int*)(mix + MOE_SIDX), (bf16_t*)(ws + WS_BAR + 32768)};
            pg::gemm_phase(C.lds, S, E);
        }
        SEAM(pb + 15);
    }
    if (EN(5) && IN(NPHASES - 1)) { PHASE_CTX(C); phase_final(C, xl, XB2); }
#undef IN
#undef SEAM
#undef PHASE_CTX
}

#ifndef MK_ONE_LAUNCH
#define MK_ONE_LAUNCH 1
#endif
typedef void (*kern_t)(Args);
extern "C" void kernel_launch(void* const* d_in, const int* in_sizes, int n_in, void* d_out, int out_size, void* d_ws, size_t ws_size, hipStream_t stream) {
    static int grid = 0;
    static const kern_t kerns[1] = { fwd<0xFFFF> };
    constexpr int NK = 1;
    if (grid == 0) {
        if (n_in != N_INPUTS || out_size != NB * LAT * DM || ws_size < WS_END) { fprintf(stderr, "kernel_launch: unexpected shapes or workspace (n_in %d out %d ws %zu, need %zu)\n", n_in, out_size, ws_size, (size_t)WS_END); grid = -1; return; }
        int dev = 0, cus = 0;
        if (hipGetDevice(&dev) != hipSuccess || hipDeviceGetAttribute(&cus, hipDeviceAttributeMultiprocessorCount, dev) != hipSuccess) { grid = -1; return; }
        for (int i = 0; i < NK; ++i) if (kerns[i]) {
            if (hipFuncSetAttribute((const void*)kerns[i], hipFuncAttributeMaxDynamicSharedMemorySize, LDS_BYTES) != hipSuccess) { fprintf(stderr, "kernel_launch: hipFuncSetAttribute failed\n"); grid = -1; return; }
            int per_cu = 0;
            if (hipOccupancyMaxActiveBlocksPerMultiprocessor(&per_cu, (const void*)kerns[i], 512, LDS_BYTES) != hipSuccess || per_cu < 1) fprintf(stderr, "kernel_launch: occupancy query says %d for kernel %d\n", per_cu, i);
        }
        (void)hipGetLastError();
        grid = cus;
        if (grid != 256) { fprintf(stderr, "kernel_launch: built for 256 CUs (one workgroup each), device has %d\n", grid); grid = -1; return; }
        if (NTOK % grid != 0) { fprintf(stderr, "kernel_launch: grid %d does not divide the token count\n", grid); grid = -1; return; }
    }
    if (grid < 0) return;
    (void)hipMemsetAsync((char*)d_ws + WS_BAR, 0, 65536, stream);
    Args a{};
    for (int i = 0; i < N_INPUTS; ++i) a.in[i] = (const float*)d_in[i];
    a.out = (float*)d_out; a.ws = (unsigned char*)d_ws;
    a.ph_lo = 0; a.ph_hi = NPHASES;
    hipLaunchKernelGGL(kerns[0], dim3(grid), dim3(512), LDS_BYTES, stream, a);
    const hipError_t le = hipPeekAtLastError();
    if (le != hipSuccess) fprintf(stderr, "kernel_launch: launch failed: %s\n", hipGetErrorName(le));
}
```

```cpp
#include <hip/hip_runtime.h>
#include <stdint.h>
#include <stdio.h>

#define LAS __attribute__((address_space(3)))
typedef unsigned short bf16_t;
typedef short bf16x8 __attribute__((ext_vector_type(8)));
typedef short s16x4 __attribute__((ext_vector_type(4)));
typedef float f32x2 __attribute__((ext_vector_type(2)));
typedef float f32x4 __attribute__((ext_vector_type(4)));
typedef float f32x16 __attribute__((ext_vector_type(16)));
typedef unsigned u32x2 __attribute__((ext_vector_type(2)));
typedef unsigned u32x4 __attribute__((ext_vector_type(4)));
typedef __bf16 bf16v2 __attribute__((ext_vector_type(2)));

constexpr int DM = 1024, NB = 16, LAT = 2048, CTX = 256, TPB = 2304, NTOK = NB * TPB, DEPTH = 4;
constexpr int NPAN = NTOK / 256;
constexpr int HROWS = NTOK / 2, HPAN = NPAN / 2;
constexpr int N_IN = 7584, Q_OFF = 160, CONV_OFF = 416, POOL_OFF = 1952, SGU_OFF = 2464, GATE_OFF = 3488;
constexpr int PLD = 3584;
constexpr int NH = 8, QKD = 96, VD = 64;
constexpr float EPS = 1e-6f;
constexpr float QSCALE = 0.10206207261596575f * 1.4426950408889634f;
constexpr int NMOD = 6, MODLD = 17 * NMOD * DM;
constexpr int MAXT = 168;

enum { I_X = 0, I_C, I_CTX, I_CCTX, I_MODW, I_MODB, I_N1G, I_N2G, I_WIN, I_KVG, I_WUKV, I_KNG, I_QAG, I_WUQ, I_QNG, I_CONVW, I_POOLW, I_POOLS, I_SGUNG, I_SGUW, I_SGUB,
       I_WBR, I_WO, I_RW, I_RB, I_W1, I_W3, I_W2, N_INPUTS };

constexpr size_t WS_BAR = 0;
constexpr size_t WS_MOD = 65536;
constexpr size_t WS_ROPE = WS_MOD + 1671168;
constexpr size_t WS_XC = WS_ROPE + 262144;
constexpr size_t WS_H = WS_XC + 16777216;
constexpr size_t WS_W = WS_H + 75497472;
constexpr size_t W_IN = 0, W_G = W_IN + 7340032, W_UQ = W_G + 8388608, W_UKV = W_UQ + 393216, W_B = W_UKV + 524288, W_O = W_B + 4194304,
                 W_13 = W_O + 2097152, W_2 = W_13 + 16777216, W_SGU = W_2 + 8388608, W_END = W_SGU + 131072;
constexpr size_t WS_BR = WS_W + W_END;
constexpr size_t WS_MIX = WS_BR + 150994944;
constexpr size_t MIX_P = 0, MIX_QRAW = MIX_P + 132120576, MIX_KVRAW = MIX_QRAW + 28311552, MIX_Q = MIX_KVRAW + 37748736, MIX_K = MIX_Q + 28311552,
                 MIX_V = MIX_K + 37748736, MIX_END = MIX_V + 18874368;
constexpr size_t MIX_S8 = 0, MIX_MERGED = 150994944;
constexpr size_t MIX_OUT = 0;
constexpr size_t MOE_CLS = 226492416, MOE_WTS = MOE_CLS + 147456, MOE_BLK = MOE_WTS + 294912, MOE_TILE = MOE_BLK + 32768, MOE_SIDX = MOE_TILE + 4096,
                 MOE_SW = MOE_SIDX + 172032, MOE_ACT = MOE_SW + 344064;
constexpr size_t WS_H8 = WS_MIX + MIX_END;
constexpr size_t WS_SS = WS_H8 + 37748736;
constexpr size_t WS_END = WS_SS + (size_t)HROWS * 32;
static_assert(MIX_MERGED + 75497472 <= MOE_CLS && MOE_ACT + 44040192 <= MIX_END && MOE_CLS + 33554432 <= MIX_END, "alias map");

constexpr int LDS_BYTES = 147456;
constexpr int LDS_MISC = 131072;

__device__ __forceinline__ unsigned pk2(float lo, float hi) { f32x2 v = {lo, hi}; bf16v2 b = __builtin_convertvector(v, bf16v2); return __builtin_bit_cast(unsigned, b); }
__device__ __forceinline__ float bflo(unsigned u) { return __uint_as_float(u << 16); }
__device__ __forceinline__ float bfhi(unsigned u) { return __uint_as_float(u & 0xffff0000u); }
__device__ __forceinline__ float bf2f(bf16_t b) { return __uint_as_float(((unsigned)b) << 16); }
__device__ __forceinline__ float fast_sigmoid(float x) { return __builtin_amdgcn_rcpf(1.0f + __builtin_amdgcn_exp2f(-1.4426950408889634f * x)); }
__device__ __forceinline__ float gelu_tanh(float x) { const float u = 0.7978845608028654f * (x + 0.044715f * x * x * x); return x * fast_sigmoid(2.0f * u); }
__device__ __forceinline__ f32x4 gelu_tanh4(f32x4 x) {
    const f32x4 k1 = {-2.302208198144325f, -2.302208198144325f, -2.302208198144325f, -2.302208198144325f}, k3 = {-0.1029432395800235f, -0.1029432395800235f, -0.1029432395800235f, -0.1029432395800235f}, one = {1.f, 1.f, 1.f, 1.f};
    const f32x4 z = x * (x * x * k3 + k1); f32x4 e;
#pragma unroll
    for (int j = 0; j < 4; ++j) e[j] = __builtin_amdgcn_exp2f(z[j]);
    const f32x4 d = e + one; f32x4 r;
#pragma unroll
    for (int j = 0; j < 4; ++j) r[j] = __builtin_amdgcn_rcpf(d[j]);
    return x * r;
}
__device__ __forceinline__ unsigned pk4_fp8(float a, float b, float c, float d) { int w = __builtin_amdgcn_cvt_pk_fp8_f32(a, b, 0, false); w = __builtin_amdgcn_cvt_pk_fp8_f32(c, d, w, true); return (unsigned)w; }
__device__ __forceinline__ void st16_wt(void* p, u32x4 w) { asm volatile("global_store_dwordx4 %0, %1, off sc1\n\ts_nop 1" :: "v"((unsigned long long)p), "v"(w) : "memory"); }
__device__ __forceinline__ int ld_agent(const int* p) { return __hip_atomic_load(p, __ATOMIC_RELAXED, __HIP_MEMORY_SCOPE_AGENT); }
__device__ __forceinline__ float shx(float v, int m, int lane) { return __int_as_float(__builtin_amdgcn_ds_bpermute((lane ^ m) << 2, __float_as_int(v))); }
__device__ __forceinline__ int shxi(int v, int m, int lane) { return __builtin_amdgcn_ds_bpermute((lane ^ m) << 2, v); }
__device__ __forceinline__ float wave_sum(float v, int lane) {
#pragma unroll
    for (int o = 32; o >= 1; o >>= 1) v += shx(v, o, lane);
    return v; }
__device__ __forceinline__ void unpack8(const u32x4 w, float (&f)[8]) { f[0] = bflo(w.x); f[1] = bfhi(w.x); f[2] = bflo(w.y); f[3] = bfhi(w.y); f[4] = bflo(w.z); f[5] = bfhi(w.z); f[6] = bflo(w.w); f[7] = bfhi(w.w); }

#define XB_TMO      128
#define XB_XCNT(j)  (256  + 64 * (j))
#define XB_XSUB(j)  (1280 + 64 * (j))
#define XB_XGEN(j)  (2304 + 64 * (j))
#define XB_TOP      3328
#define XB_TOPGEN   3392
#define XCD_BAR_WORDS 3456
#define XB_SPIN_CAP (1u << 22)
__device__ __forceinline__ unsigned xb_ld(unsigned* p)              { return __hip_atomic_load(p, __ATOMIC_RELAXED, __HIP_MEMORY_SCOPE_AGENT); }
__device__ __forceinline__ unsigned xb_add(unsigned* p, unsigned v) { return __hip_atomic_fetch_add(p, v, __ATOMIC_RELAXED, __HIP_MEMORY_SCOPE_AGENT); }
__device__ __forceinline__ unsigned xb_xcc_id() { return (unsigned)__builtin_amdgcn_s_getreg((3 << 11) | 20) & 0xFu; }
#define XB_SPIN(cond, bar) do { unsigned _sp = 0; while (cond) { __builtin_amdgcn_s_sleep(1); \
    if ((++_sp & 255u) == 0u) { if (xb_ld(&(bar)[XB_TMO])) break; if (_sp > XB_SPIN_CAP) { atomicAdd(&(bar)[XB_TMO], 1u); break; } } } } while (0)
struct XcdBarrier { unsigned* bar; unsigned x; volatile LAS unsigned* st; };
__device__ __forceinline__ XcdBarrier xcd_barrier_post(unsigned* bar, volatile LAS unsigned* st) {
    XcdBarrier b; b.bar = bar; b.x = xb_xcc_id(); b.st = st;
    if (threadIdx.x == 0) (void)xb_add(&bar[XB_XCNT(b.x)], 1u);
    return b;
}
__device__ __forceinline__ void xcd_barrier_complete(unsigned* bar, unsigned x, unsigned& nloc, unsigned& nx) {
    const unsigned G = gridDim.x * gridDim.y * gridDim.z;
    unsigned sum, cnt, mine, sp = 0u;
    for (;;) {
        sum = 0u; cnt = 0u; mine = 0u;
#pragma unroll
        for (unsigned j = 0; j < 16; ++j) { const unsigned c = xb_ld(&bar[XB_XCNT(j)]); sum += c; cnt += (c > 0u) ? 1u : 0u; mine = (j == x) ? c : mine; }
        if (sum == G) break;
        __builtin_amdgcn_s_sleep(1);
        if ((++sp & 255u) == 0u) { if (xb_ld(&bar[XB_TMO])) break; if (sp > XB_SPIN_CAP) { atomicAdd(&bar[XB_TMO], 1u); break; } }
    }
    nloc = mine > 0u ? mine : 1u; nx = cnt > 0u ? cnt : 1u;
}
__device__ __forceinline__ void xcd_barrier(const XcdBarrier& b) {
    asm volatile("s_waitcnt vmcnt(0)" ::: "memory");
    __syncthreads();
    if (threadIdx.x == 0) {
        unsigned* bar = b.bar;
        __builtin_amdgcn_s_waitcnt(0);
        unsigned nloc = b.st[0], nx = b.st[1];
        if (nloc == 0u) { xcd_barrier_complete(bar, b.x, nloc, nx); b.st[0] = nloc; b.st[1] = nx; }
        const unsigned old = xb_add(&bar[XB_XSUB(b.x)], 1u);
        const unsigned gen = old / nloc;
        if (old + 1u == (gen + 1u) * nloc) {
            __builtin_amdgcn_fence(__ATOMIC_RELEASE, "agent");
            asm volatile("s_waitcnt vmcnt(0)" ::: "memory");
            const unsigned og = xb_add(&bar[XB_TOP], 1u);
            const unsigned tg = og / nx;
            if (og + 1u == (tg + 1u) * nx) xb_add(&bar[XB_TOPGEN], 1u);
            else XB_SPIN(xb_ld(&bar[XB_TOPGEN]) == tg, bar);
            __builtin_amdgcn_fence(__ATOMIC_ACQUIRE, "agent");
            xb_add(&bar[XB_XGEN(b.x)], 1u);
            asm volatile("s_waitcnt vmcnt(0)" ::: "memory");
        } else {
            XB_SPIN(xb_ld(&bar[XB_XGEN(b.x)]) == gen, bar);
            __builtin_amdgcn_fence(__ATOMIC_ACQUIRE, "agent");
            asm volatile("s_waitcnt vmcnt(0)" ::: "memory");
        }
    }
    __syncthreads();
}

namespace pg {
constexpr int BM = 256, BK = 64, HALF = 128, HTB = HALF * BK * 2, STAGE_BYTES = 8 * HTB, NXCD = 8, WGM = 8;
__device__ __forceinline__ int lds_byte(int r, int c) { const int st = (r >> 4) * 2 + (c >> 5), rr = r & 15, cc = c & 31, ob = rr * 64 + cc * 2; return st * 1024 + (ob ^ (((ob >> 9) & 1) << 5)); }
__device__ __forceinline__ void stage_rc(int b, int& R, int& C) { const int st = b / 1024, sb = b % 1024, swz = sb ^ (((sb >> 9) & 1) << 5); R = (st >> 1) * 16 + swz / 64; C = (st & 1) * 32 + (swz % 64) / 2; }
__device__ __forceinline__ int perm32(int rho) { const int n = rho >> 4, i = rho & 15; return 8 * (i >> 2) + 4 * n + (i & 3); }
struct Unit { int pm, pn, aux; };

__device__ __forceinline__ bool grid_tile(long L, int nM, int nN, int& pm, int& pn) {
    const int nwg = nM * nN; if (L >= nwg) return false;
    int wgid = (int)L; { const int q = nwg / NXCD, r = nwg % NXCD, xcd = wgid % NXCD, off = wgid / NXCD; wgid = (xcd < r ? xcd * (q + 1) : r * (q + 1) + (xcd - r) * q) + off; }
    const int nig = WGM * nN, gid = wgid / nig, fm = gid * WGM, gsz = (nM - fm) < WGM ? (nM - fm) : WGM;
    pm = fm + ((wgid % nig) % gsz); pn = (wgid % nig) / gsz; return true;
}
struct SchedGrid {
    static constexpr bool GATHER = false, FP8 = false;
    const char* A; const char* B; unsigned lda_, ldb_; int nt_, nM, nN, G, c, latent_only;
    __device__ __forceinline__ void init(const void* A_, unsigned lda__, const void* B_, unsigned ldb__, int K, int nM_, int nN_, int lat = 0) { A = (const char*)A_; B = (const char*)B_; lda_ = lda__; ldb_ = ldb__; nt_ = K / BK; nM = nM_; nN = nN_; G = gridDim.x; c = blockIdx.x; latent_only = lat; }
    __device__ __forceinline__ bool next(int i, Unit& u) const { u.aux = 0; const bool ok = grid_tile((long)i * G + c, nM, nN, u.pm, u.pn); if (latent_only) u.pm = (u.pm >> 3) * 9 + 1 + (u.pm & 7); return ok; }
    __device__ __forceinline__ void setup(const Unit& u, const char*& a, const char*& b0, const char*& b1, unsigned& lda, unsigned& ldb, int& nt, int& nt0) const { a = A + (size_t)u.pm * 256 * lda_; b0 = B + (size_t)u.pn * 256 * ldb_; b1 = b0; lda = lda_; ldb = ldb_; nt = nt_; nt0 = nt_; }
    __device__ __forceinline__ unsigned rowoff(const Unit&, int) const { return 0u; }
    __device__ __forceinline__ bool keep_acc(const Unit&) const { return false; }
};

struct SchedGrid8 : SchedGrid { static constexpr bool FP8 = true; };
typedef int v8i32 __attribute__((ext_vector_type(8)));
typedef int v4i32 __attribute__((ext_vector_type(4)));
constexpr int MX_SCALE_ONE = 0x7f7f7f7f, MX_SCALE_W = 0x7a7a7a7a;
__device__ __forceinline__ int lds_byte8(int r, int fq) { const int rr = r & 15; return ((r >> 4) * 2 + (fq >> 1)) * 1024 + ((rr * 64 + (fq & 1) * 32) ^ ((rr >> 3) << 5)); }

template <class E, class = void> struct Perm16 { static constexpr bool v = false; };
template <class E> struct Perm16<E, decltype((void)E::PERM16)> { static constexpr bool v = E::PERM16; };
template <class E, class = void> struct AccInit { static constexpr float v = 0.f; };
template <class E> struct AccInit<E, decltype((void)E::ACC0)> { static constexpr float v = E::ACC0; };
template <class Epi, class Sched>
__device__ __forceinline__ void gemm_phase(LAS unsigned char* lds, const Sched& S, const Epi& E) {
    constexpr bool GATHER = Sched::GATHER, FP8 = Sched::FP8; constexpr int KOFF = FP8 ? 16 : 1024;
    int tid = threadIdx.x; asm volatile("" : "+v"(tid));
    const int wid = __builtin_amdgcn_readfirstlane(tid >> 6), lane = tid & 63, wr = wid >> 2, wc = wid & 3, fr = lane & 15, fq = lane >> 4;
    unsigned Rp0, C20, Rbp0; { int R, C; stage_rc(tid * 16, R, C); Rp0 = (unsigned)R; C20 = (unsigned)C * 2u; Rbp0 = (unsigned)(Perm16<Epi>::v ? (64 * (R >> 5) + 16 * ((R & 15) >> 2) + 4 * ((R >> 4) & 1) + (R & 3)) : (Epi::PERM ? ((R & ~31) + perm32(R & 31)) : R)); }
    const unsigned ldsw = (unsigned)wid * 1024u;
    const unsigned foff = (unsigned)(FP8 ? lds_byte8(fr, fq) : lds_byte(fr, fq * 8)); const unsigned sa = (unsigned)wr * 8192u, sb = (unsigned)wc * 4096u;
#define PG_SA(b, h) (((b) * 2 + (h)) * HTB)
#define PG_SB(b, h) ((4 + (b) * 2 + (h)) * HTB)
#define PG_GLDS(gptr, bufoff, i) __builtin_amdgcn_global_load_lds((const unsigned*)(gptr), (LAS unsigned*)(lds + (bufoff) + ldsw + (i) * 8192), 16, 0, 0)
#define PG_STAGE_A(bufoff, base, h, ldx, garr) do { const char* _sb = GATHER ? (base) : (base) + (size_t)(h) * 128u * (ldx); _Pragma("unroll") for (int _i = 0; _i < 2; ++_i) { \
        unsigned _r = Rp0; asm volatile("" : "+v"(_r)); const unsigned _vo = GATHER ? garr[h][_i] + C20 : _r * (ldx) + C20; PG_GLDS(_sb + (GATHER ? (size_t)0 : (size_t)_i * 64u * (ldx)) + _vo, bufoff, _i); } } while (0)
#define PG_STAGE_B(bufoff, base, h, ldx) do { const char* _sb = (base) + (size_t)(h) * (Perm16<Epi>::v ? 8u : 128u) * (ldx); _Pragma("unroll") for (int _i = 0; _i < 2; ++_i) { \
        unsigned _r = Rbp0; asm volatile("" : "+v"(_r)); const unsigned _vo = _r * (ldx) + C20; PG_GLDS(_sb + (size_t)_i * (Perm16<Epi>::v ? 128u : 64u) * (ldx) + _vo, bufoff, _i); } } while (0)
#define PG_LDA(dst, b, h) do { unsigned aoff = foff + sa; asm volatile("" : "+v"(aoff)); _Pragma("unroll") for (int m = 0; m < 4; ++m) _Pragma("unroll") for (int k = 0; k < 2; ++k) dst[m][k] = *(const LAS bf16x8*)(lds + PG_SA(b, h) + aoff + m * 2048 + k * KOFF); } while (0)
#define PG_LDB(dst, b, h) do { unsigned boff = foff + sb; asm volatile("" : "+v"(boff)); _Pragma("unroll") for (int n = 0; n < 2; ++n) _Pragma("unroll") for (int k = 0; k < 2; ++k) dst[n][k] = *(const LAS bf16x8*)(lds + PG_SB(b, h) + boff + n * 2048 + k * KOFF); } while (0)
#define PG_CAT8(x) __builtin_shufflevector(__builtin_bit_cast(v4i32, (x)[0]), __builtin_bit_cast(v4i32, (x)[1]), 0, 1, 2, 3, 4, 5, 6, 7)
#define PG_MMA(ai, bj, At, Bt) do { __builtin_amdgcn_s_setprio(1); if constexpr (FP8) { _Pragma("unroll") for (int m = 0; m < 4; ++m) _Pragma("unroll") for (int n = 0; n < 2; ++n) \
            acc[ai][bj][m][n] = __builtin_amdgcn_mfma_scale_f32_16x16x128_f8f6f4(PG_CAT8(Bt[n]), PG_CAT8(At[m]), acc[ai][bj][m][n], 0, 0, 0, MX_SCALE_W, 0, MX_SCALE_ONE); } \
        else { _Pragma("unroll") for (int m = 0; m < 4; ++m) _Pragma("unroll") for (int n = 0; n < 2; ++n) _Pragma("unroll") for (int k = 0; k < 2; ++k) \
            acc[ai][bj][m][n] = __builtin_amdgcn_mfma_f32_16x16x32_bf16(Bt[n][k], At[m][k], acc[ai][bj][m][n], 0, 0, 0); } __builtin_amdgcn_s_setprio(0); } while (0)
#define PG_WAIT_V(n) asm volatile("s_waitcnt vmcnt(" #n ")" ::: "memory")
#define PG_WAIT_L(n) asm volatile("s_waitcnt lgkmcnt(" #n ")" ::: "memory")
#define PG_BAR __builtin_amdgcn_s_barrier()
#define PG_SCHED __builtin_amdgcn_sched_barrier(0)
#define PG_BSEL(b0, b1, t, n0) ((t) < (n0) ? (b0) + (size_t)(t) * 128 : (b1) + (size_t)((t) - (n0)) * 128)
    Unit cur, nxt; int ui = 0;
    if (!S.next(0, cur)) return;
    f32x4 acc[2][2][4][2];
    float zacc = AccInit<Epi>::v; asm volatile("" : "+v"(zacc));
#pragma unroll
    for (int a = 0; a < 2; ++a)
#pragma unroll
        for (int b = 0; b < 2; ++b)
#pragma unroll
            for (int m = 0; m < 4; ++m)
#pragma unroll
                for (int n = 0; n < 2; ++n) acc[a][b][m][n] = (f32x4){zacc, zacc, zacc, zacc};
    bf16x8 At[4][2], B0[2][2], B1[2][2];
    const char *cA, *cB0, *cB1; int nt, nt0; unsigned lda, ldb; unsigned gA[2][2], ngA[2][2];
    S.setup(cur, cA, cB0, cB1, lda, ldb, nt, nt0);
#pragma unroll
    for (int h = 0; h < 2; ++h)
#pragma unroll
        for (int i = 0; i < 2; ++i) { gA[h][i] = GATHER ? S.rowoff(cur, h * HALF + (int)Rp0 + 64 * i) : 0u; ngA[h][i] = gA[h][i]; }
    { const char* b0p = PG_BSEL(cB0, cB1, 0, nt0); const char* b1p = PG_BSEL(cB0, cB1, 1, nt0);
      PG_STAGE_B(PG_SB(0, 0), b0p, 0, ldb); PG_STAGE_A(PG_SA(0, 0), cA, 0, lda, gA); PG_STAGE_B(PG_SB(0, 1), b0p, 1, ldb); PG_STAGE_A(PG_SA(0, 1), cA, 1, lda, gA);
      if (wr == 1) PG_BAR;
      PG_WAIT_V(4); PG_BAR;
      PG_STAGE_B(PG_SB(1, 0), b1p, 0, ldb); PG_STAGE_A(PG_SA(1, 0), cA + 128, 0, lda, gA); PG_STAGE_B(PG_SB(1, 1), b1p, 1, ldb);
      PG_WAIT_V(6); PG_BAR; }
    for (;;) {
        const bool has_next = S.next(ui + 1, nxt);
        const char *nA = cA, *nB0 = cB0, *nB1 = cB1; int nnt = nt, nnt0 = nt0; unsigned nlda = lda, nldb = ldb;
        if (has_next) S.setup(nxt, nA, nB0, nB1, nlda, nldb, nnt, nnt0);
        for (int t = 0; t < nt; t += 2) {
            const bool last = (t == nt - 2);
            if constexpr (GATHER) {
                if (last && has_next) {
#pragma unroll
                    for (int h = 0; h < 2; ++h)
#pragma unroll
                        for (int i = 0; i < 2; ++i) ngA[h][i] = S.rowoff(nxt, h * HALF + (int)Rp0 + 64 * i);
                }
            }
            const char* a1 = cA + (size_t)(t + 1) * 128;
            const char* a2 = last ? nA : cA + (size_t)(t + 2) * 128; const char* a3 = a2 + 128;
            const char* b2 = last ? PG_BSEL(nB0, nB1, 0, nnt0) : PG_BSEL(cB0, cB1, t + 2, nt0);
            const char* b3 = last ? PG_BSEL(nB0, nB1, 1, nnt0) : PG_BSEL(cB0, cB1, t + 3, nt0);
            const unsigned xlda = last ? nlda : lda, xldb = last ? nldb : ldb;
            unsigned wA[2][2]; const unsigned lmask = (GATHER && last) ? 0xffffffffu : 0u;
#pragma unroll
            for (int h = 0; h < 2; ++h)
#pragma unroll
                for (int i = 0; i < 2; ++i) wA[h][i] = gA[h][i] ^ ((gA[h][i] ^ ngA[h][i]) & lmask);
            PG_LDB(B0, 0, 0); PG_SCHED; PG_LDA(At, 0, 0); PG_STAGE_A(PG_SA(1, 1), a1, 1, lda, gA);
            PG_WAIT_L(8); PG_BAR; PG_WAIT_L(0); PG_MMA(0, 0, At, B0); PG_BAR; PG_SCHED;
            PG_LDB(B1, 0, 1); PG_STAGE_B(PG_SB(0, 0), b2, 0, xldb);
            PG_BAR; PG_WAIT_L(0); PG_MMA(0, 1, At, B1); PG_BAR;
            PG_LDA(At, 0, 1); PG_STAGE_A(PG_SA(0, 0), a2, 0, xlda, wA);
            PG_BAR; PG_WAIT_L(0); PG_MMA(1, 0, At, B0); PG_BAR; PG_SCHED;
            PG_STAGE_B(PG_SB(0, 1), b2, 1, xldb);
            PG_WAIT_V(6); PG_BAR; PG_MMA(1, 1, At, B1); PG_BAR;
            PG_LDB(B0, 1, 0); PG_SCHED; PG_LDA(At, 1, 0); PG_STAGE_A(PG_SA(0, 1), a2, 1, xlda, wA);
            PG_WAIT_L(8); PG_BAR; PG_WAIT_L(0); PG_MMA(0, 0, At, B0); PG_BAR; PG_SCHED;
            PG_LDB(B1, 1, 1); PG_STAGE_B(PG_SB(1, 0), b3, 0, xldb);
            PG_BAR; PG_WAIT_L(0); PG_MMA(0, 1, At, B1); PG_BAR;
            PG_LDA(At, 1, 1); PG_STAGE_A(PG_SA(1, 0), a3, 0, xlda, wA);
            PG_BAR; PG_WAIT_L(0); PG_MMA(1, 0, At, B0); PG_BAR; PG_SCHED;
            PG_STAGE_B(PG_SB(1, 1), b3, 1, xldb);
            PG_WAIT_V(6); PG_BAR; PG_MMA(1, 1, At, B1); PG_BAR;
        }
        PG_SCHED; { int t2 = threadIdx.x; asm volatile("" : "+v"(t2)); E(acc, cur, wr, wc, t2 & 15, (t2 >> 4) & 3); } PG_SCHED;
        if (!has_next) break;
        if (!S.keep_acc(nxt)) {
            float z2 = AccInit<Epi>::v; asm volatile("" : "+v"(z2));
#pragma unroll
            for (int a = 0; a < 2; ++a)
#pragma unroll
                for (int b = 0; b < 2; ++b)
#pragma unroll
                    for (int m = 0; m < 4; ++m)
#pragma unroll
                        for (int n = 0; n < 2; ++n) acc[a][b][m][n] = (f32x4){z2, z2, z2, z2};
        }
        cur = nxt; cA = nA; cB0 = nB0; cB1 = nB1; nt = nnt; nt0 = nnt0; lda = nlda; ldb = nldb; ++ui;
#pragma unroll
        for (int h = 0; h < 2; ++h)
#pragma unroll
            for (int i = 0; i < 2; ++i) gA[h][i] = ngA[h][i];
    }
    PG_WAIT_V(0);
    if (wr == 0) PG_BAR;
    PG_BAR;
#undef PG_SA
#undef PG_SB
#undef PG_GLDS
#undef PG_STAGE_A
#undef PG_STAGE_B
#undef PG_LDA
#undef PG_LDB
#undef PG_MMA
#undef PG_CAT8
#undef PG_WAIT_V
#undef PG_WAIT_L
#undef PG_BAR
#undef PG_SCHED
#undef PG_BSEL
}

struct EpiP2 {
    static constexpr bool PERM = true;
    bf16_t* O; float* SS; float* SA;
    __device__ __forceinline__ void operator()(f32x4 (&acc)[2][2][4][2], const Unit& u, int wr, int wc, int fr, int fq) const {
        const int row0 = u.pm * BM + wr * 64 + fr, col0 = u.pn * BM + wc * 32 + 8 * fq; const bool g = u.pn >= 10, st = u.pn >= 12, la = u.pn < 2; const int ln = fq * 16 + fr;
#pragma unroll
        for (int ai = 0; ai < 2; ++ai)
#pragma unroll
            for (int m = 0; m < 4; ++m) { const int row = row0 + ai * HALF + m * 16; bf16_t* rowp = O + (size_t)row * PLD + col0; float ssq = 0.f;
#pragma unroll
                for (int bj = 0; bj < 2; ++bj) { f32x4 v0 = acc[ai][bj][m][0], v1 = acc[ai][bj][m][1];
                    if (g) { v0 = gelu_tanh4(v0); v1 = gelu_tanh4(v1); }
                    if (st) { const f32x4 q = v0 * v0 + v1 * v1; ssq += (q[0] + q[1]) + (q[2] + q[3]); }
                    if (la) { float sl = 0.f;
#pragma unroll
                        for (int j = 0; j < 4; ++j) sl += v0[j] * v0[j] + v1[j] * v1[j];
                        sl += shx(sl, 16, ln); sl += shx(sl, 32, ln);
                        if (fq == 0) SA[(size_t)row * 16 + u.pn * 8 + bj * 4 + wc] = sl; }
                    u32x4 w; w.x = pk2(v0[0], v0[1]); w.y = pk2(v0[2], v0[3]); w.z = pk2(v1[0], v1[1]); w.w = pk2(v1[2], v1[3]);
                    *(u32x4*)(rowp + bj * HALF) = w; }
                if (st) { ssq += shx(ssq, 16, ln); ssq += shx(ssq, 32, ln);
                    if (fq == 0) SS[(size_t)row * 8 + (u.pn - 12) * 4 + wc] = ssq; } }
    }
};
struct EpiBf16 {
    static constexpr bool PERM = true;
    bf16_t* O; int ldc; int gelu_pn; float* SS;
    __device__ __forceinline__ void operator()(f32x4 (&acc)[2][2][4][2], const Unit& u, int wr, int wc, int fr, int fq) const {
        const int row0 = u.pm * BM + wr * 64 + fr, col0 = u.pn * BM + wc * 32 + 8 * fq; const bool g = u.pn >= gelu_pn, st = u.pn >= gelu_pn + 2;
#pragma unroll
        for (int ai = 0; ai < 2; ++ai)
#pragma unroll
            for (int m = 0; m < 4; ++m) { bf16_t* rowp = O + (size_t)(row0 + ai * HALF + m * 16) * ldc + col0; float ssq = 0.f;
#pragma unroll
                for (int bj = 0; bj < 2; ++bj) { f32x4 v0 = acc[ai][bj][m][0], v1 = acc[ai][bj][m][1];
                    if (g) { v0 = gelu_tanh4(v0); v1 = gelu_tanh4(v1); }
                    if (st) { const f32x4 q = v0 * v0 + v1 * v1; ssq += (q[0] + q[1]) + (q[2] + q[3]); }
                    u32x4 w; w.x = pk2(v0[0], v0[1]); w.y = pk2(v0[2], v0[3]); w.z = pk2(v1[0], v1[1]); w.w = pk2(v1[2], v1[3]);
                    *(u32x4*)(rowp + bj * HALF) = w; }
                if (st) { const int ln = fq * 16 + fr; ssq += shx(ssq, 16, ln); ssq += shx(ssq, 32, ln);
                    if (fq == 0) SS[(size_t)(row0 + ai * HALF + m * 16) * 8 + (u.pn - gelu_pn - 2) * 4 + wc] = ssq; } }
    }
};
}
using pg::Unit;

struct Args { const float* in[N_INPUTS]; float* out; unsigned char* ws; int ph_lo, ph_hi; };

struct Ctx {
    const float* const __attribute__((address_space(4)))* kin;
    unsigned char* ws; LAS unsigned char* lds; int tid, lane, wave, G, bid;
    __device__ __forceinline__ const float* in(int k) const { return (const float*)(const __attribute__((address_space(1))) float*)kin[k]; }
};

__device__ __forceinline__ void phase_prologue(const Ctx& C) {
    const float* cin = C.in(I_C); const float* cctx = C.in(I_CCTX); const float* modw = C.in(I_MODW); const float* modb = C.in(I_MODB);
    float* MOD = (float*)(C.ws + WS_MOD); float* ROPE = (float*)(C.ws + WS_ROPE);
    for (int i = C.bid * 512 + C.tid; i < 2048 * 16; i += C.G * 512) {
        const int pos = i >> 4, p = i & 15; const float inv = powf(10000.0f, -(float)(p & 7) / 8.0f);
        const float ang = (float)(p < 8 ? (pos >> 6) : (pos & 63)) * inv;
        ROPE[i] = cosf(ang); ROPE[32768 + i] = sinf(ang);
    }
    if (C.bid == 0 && C.wave == 0) {
        const int l = C.lane, i = l & 15, kb = l >> 4; pg::v8i32 A, B;
#pragma unroll
        for (int d = 0; d < 8; ++d) { unsigned wa = 0, wb = 0;
#pragma unroll
            for (int bb = 0; bb < 4; ++bb) { const int k = 32 * kb + 4 * d + bb; const int va = (i * 7 + k * 3) % 5, vb = (k * 5 + i * 11) % 3;
                wa |= (unsigned)(va == 0 ? 0 : va == 1 ? 0x38 : va == 2 ? 0x40 : va == 3 ? 0x44 : 0x48) << (8 * bb); wb |= (unsigned)(vb == 0 ? 0 : vb == 1 ? 0x38 : 0x40) << (8 * bb); }
            A[d] = (int)wa; B[d] = (int)wb; }
        f32x4 cz = {0.f, 0.f, 0.f, 0.f};
        const f32x4 got = __builtin_amdgcn_mfma_scale_f32_16x16x128_f8f6f4(A, B, cz, 0, 0, 0, pg::MX_SCALE_ONE, 0, pg::MX_SCALE_ONE);
        bool bad = pk4_fp8(1.f, 2.f, 3.f, 4.f) != 0x48444038u;
#pragma unroll
        for (int r = 0; r < 4; ++r) { const int row = 4 * kb + r; int e = 0; for (int k = 0; k < 128; ++k) e += ((row * 7 + k * 3) % 5) * ((k * 5 + i * 11) % 3); bad |= got[r] != (float)e; }
        const f32x4 got2 = __builtin_amdgcn_mfma_scale_f32_16x16x128_f8f6f4(A, B, cz, 0, 0, 0, pg::MX_SCALE_W, 0, pg::MX_SCALE_ONE);
#pragma unroll
        for (int r = 0; r < 4; ++r) bad |= got2[r] * 32.f != got[r];
        if (bad) __hip_atomic_store((unsigned*)(C.ws + WS_BAR + 49152), 1u, __ATOMIC_RELAXED, __HIP_MEMORY_SCOPE_AGENT);
    }
    LAS float* sA = (LAS float*)C.lds;
    for (int i = C.tid; i < 17 * 1024; i += 512) { const float v = i < 16384 ? cin[i] : cctx[i - 16384]; sA[i] = v * fast_sigmoid(v); }
    __syncthreads();
    LAS float* red = (LAS float*)(C.lds + 17 * 1024 * 4);
    for (int unit = C.bid; unit < DEPTH * 96; unit += C.G) {
        const int layer = unit / 96, col = (unit % 96) * 64 + C.lane;
        const float* W = modw + (size_t)layer * DM * 6144 + col;
        float acc[17];
#pragma unroll
        for (int b = 0; b < 17; ++b) acc[b] = 0.f;
        const int k0 = C.wave * 128;
        for (int k = k0; k < k0 + 128; k += 4) {
            float w[4];
#pragma unroll
            for (int j = 0; j < 4; ++j) w[j] = W[(size_t)(k + j) * 6144];
#pragma unroll
            for (int j = 0; j < 4; ++j)
#pragma unroll
                for (int b = 0; b < 17; ++b) acc[b] += sA[b * 1024 + k + j] * w[j];
        }
#pragma unroll
        for (int b = 0; b < 17; ++b) red[(C.wave * 17 + b) * 64 + C.lane] = acc[b];
        __syncthreads();
        for (int o = C.tid; o < 17 * 64; o += 512) { const int b = o >> 6, l = o & 63; float s = 0.f;
#pragma unroll
            for (int w8 = 0; w8 < 8; ++w8) s += red[(w8 * 17 + b) * 64 + l];
            const int cc = (unit % 96) * 64 + l;
            MOD[(size_t)layer * MODLD + (size_t)b * 6144 + cc] = s + modb[layer * 6144 + cc]; }
        __syncthreads();
    }
}

template <bool F8 = false>
__device__ __forceinline__ void cvt_t(const Ctx& C, const float* src, int lds_, int K, int N, bf16_t* dst, int ldd, const float* ks, int rmul, int radd, int& rot, int kshift = 30, size_t eblk = 0, float wscale = 32.f, int kvperm = 0) {
    LAS float* T = (LAS float*)C.lds;
    const int tk = K / 64, tn = (N + 63) / 64, ntile = tk * tn;
    int first = (C.bid - rot) % C.G; if (first < 0) first += C.G;
    const int tx = C.tid & 63, ty = C.tid >> 6;
    for (int t = first; t < ntile; t += 4 * C.G) {
        float v[4][8];
#pragma unroll
        for (int b = 0; b < 4; ++b) { const int tb = t + b * C.G;
            if (tb < ntile) { const int k0 = (tb % tk) * 64, n0 = (tb / tk) * 64;
#pragma unroll
                for (int r = 0; r < 2; ++r) { const int k = k0 + (C.tid >> 4) + 32 * r, n = n0 + (C.tid & 15) * 4; f32x4 x = {0.f, 0.f, 0.f, 0.f};
                    if (n < N) { x = *(const f32x4*)(src + (size_t)k * lds_ + n); if (ks) x *= ks[k]; } v[b][4 * r] = x[0]; v[b][4 * r + 1] = x[1]; v[b][4 * r + 2] = x[2]; v[b][4 * r + 3] = x[3]; } } }
#pragma unroll
        for (int b = 0; b < 4; ++b) { if (t + b * C.G < ntile) {
#pragma unroll
                for (int r = 0; r < 2; ++r)
#pragma unroll
                    for (int j = 0; j < 4; ++j) T[b * 4160 + ((C.tid >> 4) + 32 * r) * 65 + (C.tid & 15) * 4 + j] = v[b][4 * r + j]; } }
        __syncthreads();
#pragma unroll
        for (int b = 0; b < 4; ++b) { const int tb = t + b * C.G;
            if (tb < ntile) { const int k0 = (tb % tk) * 64, n0 = (tb / tk) * 64; const int n = C.tid >> 3, kc = (C.tid & 7) * 8;
                if (n0 + n < N) { float f[8];
#pragma unroll
                    for (int j = 0; j < 8; ++j) f[j] = T[b * 4160 + (kc + j) * 65 + n];
                    const int k = k0 + kc, nn = n0 + n;
                    const int drow = kvperm ? ((nn >> 8) * 256 + ((nn >> 5) & 1) * 128 + (((nn >> 7) & 1) * 2 + ((nn >> 6) & 1)) * 32 + (nn & 31)) : nn * rmul + radd;
                    const size_t off = (size_t)(k >> kshift) * eblk + (size_t)drow * ldd + (k & ((1 << kshift) - 1));
                    if constexpr (F8) { u32x2 w; w.x = pk4_fp8(wscale * f[0], wscale * f[1], wscale * f[2], wscale * f[3]); w.y = pk4_fp8(wscale * f[4], wscale * f[5], wscale * f[6], wscale * f[7]);
                        *(u32x2*)((unsigned char*)dst + off) = w; }
                    else { u32x4 w; w.x = pk2(f[0], f[1]); w.y = pk2(f[2], f[3]); w.z = pk2(f[4], f[5]); w.w = pk2(f[6], f[7]);
                        st16_wt(dst + off, w); } } } }
        __syncthreads();
    }
    rot = (rot + ntile) % C.G;
}
__device__ __forceinline__ void phase_cvt(const Ctx& C, int layer) {
    unsigned char* W = C.ws + WS_W; int rot = 0;
    const float* win = C.in(I_WIN) + (size_t)layer * DM * N_IN;
    bf16_t* WIN = (bf16_t*)(W + W_IN);
    cvt_t(C, win + CONV_OFF, N_IN, DM, 3072, WIN + (size_t)512 * DM, DM, nullptr, 1, 0, rot);
    cvt_t<true>(C, win + GATE_OFF, N_IN, DM, 4096, (bf16_t*)(W + W_G), DM, nullptr, 1, 0, rot, 30, 0, -46.16624130844683f);
    cvt_t(C, C.in(I_W1) + (size_t)layer * 16 * DM * 256, 256, 16 * DM, 256, (bf16_t*)(W + W_13), DM, nullptr, 2, 0, rot, 10, (size_t)512 * DM);
    cvt_t(C, C.in(I_W3) + (size_t)layer * 16 * DM * 256, 256, 16 * DM, 256, (bf16_t*)(W + W_13), DM, nullptr, 2, 1, rot, 10, (size_t)512 * DM);
    cvt_t(C, C.in(I_W2) + (size_t)layer * 16 * 256 * DM, DM, 16 * 256, DM, (bf16_t*)(W + W_2), 256, nullptr, 1, 0, rot, 8, (size_t)DM * 256);
    cvt_t(C, C.in(I_WO) + (size_t)layer * DM * DM, DM, DM, DM, (bf16_t*)(W + W_O), DM, nullptr, 1, 0, rot);
    cvt_t(C, win, N_IN, DM, 416, WIN, DM, nullptr, 1, 0, rot);
    cvt_t(C, C.in(I_WUQ) + (size_t)layer * 256 * 768, 768, 256, 768, (bf16_t*)(W + W_UQ), 256, C.in(I_QAG) + layer * 256, 1, 0, rot);
    cvt_t(C, C.in(I_WUKV) + (size_t)layer * 128 * 1024, 1024, 128, 1024, (bf16_t*)(W + W_UKV), 256, C.in(I_KVG) + layer * 128, 1, 0, rot, 30, 0, 32.f, 1);
    for (int n = 0; n < 4; ++n) if (n != 2)
        cvt_t<true>(C, C.in(I_WBR) + ((size_t)layer * 4 + n) * 512 * DM, DM, 512, DM, (bf16_t*)(W + W_B + (size_t)n * DM * 512), 512, nullptr, 1, 0, rot);
    const int gt = C.bid * 512 + C.tid, gs = C.G * 512;
    unsigned zz = 0u; asm volatile("" : "+v"(zz)); const u32x4 zero4 = {zz, zz, zz, zz};
    for (int i = gt; i < 96 * DM / 8; i += gs) *(u32x4*)(WIN + (size_t)416 * DM + (size_t)i * 8) = zero4;
    for (int i = gt; i < 1024 * 16; i += gs) { const int n = i >> 4, kc = (i & 15) * 8; *(u32x4*)((bf16_t*)(W + W_UKV) + (size_t)n * 256 + 128 + kc) = zero4; }
    { const float* sw = C.in(I_SGUW) + (size_t)layer * 4 * 128 * 128; bf16_t* d = (bf16_t*)(W + W_SGU);
      for (int i = gt; i < 4 * 128 * 128 / 2; i += gs) *(unsigned*)(d + i * 2) = pk2(sw[i * 2], sw[i * 2 + 1]); }
    { const float* pw = C.in(I_POOLW) + (size_t)layer * 4 * 128 * 128; const float* ps = C.in(I_POOLS) + layer * 512; const float* wb = C.in(I_WBR) + ((size_t)layer * 4 + 2) * 512 * DM;
      unsigned char* d = W + W_B + (size_t)2 * DM * 512;
      for (int o = gt; o < 512 * DM / 4; o += gs) { const int dd = (o & 255) * 4, kc = o >> 8, g = kc >> 7; const float* pwr = pw + (size_t)kc * 128; const float* psg = ps + g * 128; const float* wbg = wb + (size_t)g * 128 * DM + dd;
          f32x4 sacc = {0.f, 0.f, 0.f, 0.f};
#pragma unroll 8
          for (int j = 0; j < 128; ++j) { const float cf = pwr[j] * psg[j]; const f32x4 wv = *(const f32x4*)(wbg + (size_t)j * DM); sacc += cf * wv; }
#pragma unroll
          for (int q = 0; q < 4; ++q) d[(size_t)(dd + q) * 512 + kc] = (unsigned char)(pk4_fp8(32.f * sacc[q], 0.f, 0.f, 0.f) & 0xffu); } }
}

__device__ __forceinline__ const float* xrow_c(const float* xl, const float* xc, int r) { const int b = r / TPB, t = r - b * TPB; return t < CTX ? xc + (size_t)(b * CTX + t) * DM : xl + (size_t)(b * LAT + t - CTX) * DM; }
__device__ __forceinline__ float* xrow(float* xl, float* xc, int r) { const int b = r / TPB, t = r - b * TPB; return t < CTX ? xc + (size_t)(b * CTX + t) * DM : xl + (size_t)(b * LAT + t - CTX) * DM; }
__device__ __forceinline__ int mod_index(int r) { const int b = r / TPB, t = r - b * TPB; return t < CTX ? 16 : b; }

struct NormRaw { u32x4 a0, a1, a2, a3, y0, y1; };
__device__ __forceinline__ void norm_load(NormRaw& R, const float* xf, const bf16_t* xb, const bf16_t* y, int lane) {
    if (xf) { R.a0 = *(const u32x4*)(xf + 8 * lane); R.a1 = *(const u32x4*)(xf + 8 * lane + 4); R.a2 = *(const u32x4*)(xf + 512 + 8 * lane); R.a3 = *(const u32x4*)(xf + 516 + 8 * lane); }
    else { R.a0 = *(const u32x4*)(xb + 8 * lane); R.a1 = *(const u32x4*)(xb + 512 + 8 * lane); R.a2 = R.a0; R.a3 = R.a1; }
    if (y) { R.y0 = *(const u32x4*)(y + 8 * lane); R.y1 = *(const u32x4*)(y + 512 + 8 * lane); } else { R.y0 = R.a0; R.y1 = R.a1; }
}
__device__ __forceinline__ void store_h_wt(bf16_t* hrow, int lane, const float (&h)[16]) {
    u32x4 w0, w1; w0.x = pk2(h[0], h[1]); w0.y = pk2(h[2], h[3]); w0.z = pk2(h[4], h[5]); w0.w = pk2(h[6], h[7]);
    w1.x = pk2(h[8], h[9]); w1.y = pk2(h[10], h[11]); w1.z = pk2(h[12], h[13]); w1.w = pk2(h[14], h[15]);
    st16_wt(hrow + 8 * lane, w0); st16_wt(hrow + 512 + 8 * lane, w1);
}
__device__ __forceinline__ void store_h(bf16_t* hrow, int lane, const float (&h)[16]) {
    u32x4 w0, w1; w0.x = pk2(h[0], h[1]); w0.y = pk2(h[2], h[3]); w0.z = pk2(h[4], h[5]); w0.w = pk2(h[6], h[7]);
    w1.x = pk2(h[8], h[9]); w1.y = pk2(h[10], h[11]); w1.z = pk2(h[12], h[13]); w1.w = pk2(h[14], h[15]);
    *(u32x4*)(hrow + 8 * lane) = w0; *(u32x4*)(hrow + 512 + 8 * lane) = w1;
}
__device__ __forceinline__ void norm_finish(const NormRaw& R, bool x_f32, bool has_y, const float* gate, bf16_t* xdst, const float* g, const float* shift, const float* scale, int lane, float (&h)[16]) {
    float v[16];
    if (x_f32) { const f32x4 f0 = __builtin_bit_cast(f32x4, R.a0), f1 = __builtin_bit_cast(f32x4, R.a1), f2 = __builtin_bit_cast(f32x4, R.a2), f3 = __builtin_bit_cast(f32x4, R.a3);
        v[0] = f0[0]; v[1] = f0[1]; v[2] = f0[2]; v[3] = f0[3]; v[4] = f1[0]; v[5] = f1[1]; v[6] = f1[2]; v[7] = f1[3];
        v[8] = f2[0]; v[9] = f2[1]; v[10] = f2[2]; v[11] = f2[3]; v[12] = f3[0]; v[13] = f3[1]; v[14] = f3[2]; v[15] = f3[3];
    } else { float t[8]; unpack8(R.a0, t);
#pragma unroll
        for (int j = 0; j < 8; ++j) v[j] = t[j];
        unpack8(R.a1, t);
#pragma unroll
        for (int j = 0; j < 8; ++j) v[8 + j] = t[j]; }
    if (has_y) {
        float yf[16]; { float t[8]; unpack8(R.y0, t);
#pragma unroll
            for (int j = 0; j < 8; ++j) yf[j] = t[j];
            unpack8(R.y1, t);
#pragma unroll
            for (int j = 0; j < 8; ++j) yf[8 + j] = t[j]; }
#pragma unroll
        for (int q = 0; q < 4; ++q) { const int c = (q >> 1) * 512 + 8 * lane + (q & 1) * 4; const f32x4 gt = *(const f32x4*)(gate + c);
#pragma unroll
            for (int j = 0; j < 4; ++j) v[q * 4 + j] += gt[j] * yf[q * 4 + j]; }
    }
    if (xdst) store_h(xdst, lane, v);
    float ss = 0.f;
#pragma unroll
    for (int j = 0; j < 16; ++j) ss += v[j] * v[j];
    ss = wave_sum(ss, lane);
    const float rstd = 1.0f / sqrtf(ss * (1.0f / 1024.0f) + EPS);
#pragma unroll
    for (int q = 0; q < 4; ++q) { const int c = (q >> 1) * 512 + 8 * lane + (q & 1) * 4;
        const f32x4 gg = *(const f32x4*)(g + c), sh = *(const f32x4*)(shift + c), sc = *(const f32x4*)(scale + c);
#pragma unroll
        for (int j = 0; j < 4; ++j) h[q * 4 + j] = v[q * 4 + j] * rstd * gg[j] * (1.0f + sc[j]) + sh[j]; }
}
__device__ __forceinline__ void store_h8(unsigned char* hrow, int lane, const float (&h)[16]) {
    u32x2 a, b; a.x = pk4_fp8(h[0], h[1], h[2], h[3]); a.y = pk4_fp8(h[4], h[5], h[6], h[7]); b.x = pk4_fp8(h[8], h[9], h[10], h[11]); b.y = pk4_fp8(h[12], h[13], h[14], h[15]);
    const bool odd = lane & 1; const unsigned sx = odd ? a.x : b.x, sy = odd ? a.y : b.y;
    const unsigned rx = (unsigned)__builtin_amdgcn_update_dpp(0, (int)sx, 0xB1, 0xf, 0xf, false), ry = (unsigned)__builtin_amdgcn_update_dpp(0, (int)sy, 0xB1, 0xf, 0xf, false);
    const u32x4 w = odd ? (u32x4){rx, ry, b.x, b.y} : (u32x4){a.x, a.y, rx, ry};
    st16_wt(hrow + (odd ? 512 + 8 * (lane - 1) : 8 * lane), w);
}
__device__ __forceinline__ void phase_norm1(const Ctx& C, int layer, bf16_t* XB) {
    const float* g = C.in(I_N1G) + layer * DM; const float* MOD = (const float*)(C.ws + WS_MOD) + (size_t)layer * MODLD; bf16_t* H = (bf16_t*)(C.ws + WS_H);
    const bf16_t* Y = (const bf16_t*)(C.ws + WS_MIX + MIX_OUT); const float* xin = C.in(I_X); const float* cin = C.in(I_CTX);
    const int rows_per = NTOK / C.G, rbase = C.bid * rows_per + 2 * C.wave;
    int mi_cur = -1; float Av[16], Sv[16], Gv[16];
    for (int k = 0; k < rows_per / 16; ++k) {
        const int r0 = rbase + 16 * k;
        NormRaw R[2];
#pragma unroll
        for (int q = 0; q < 2; ++q) norm_load(R[q], layer == 0 ? xrow_c(xin, cin, r0 + q) : nullptr, XB + (size_t)(r0 + q) * DM, layer == 0 ? nullptr : Y + (size_t)(r0 + q) * DM, C.lane);
#pragma unroll
        for (int q = 0; q < 2; ++q) { const int r = r0 + q; const int mi = mod_index(r);
            if (mi != mi_cur) { mi_cur = mi; const float* m = MOD + (size_t)mi * 6144;
#pragma unroll
                for (int qq = 0; qq < 4; ++qq) { const int c = (qq >> 1) * 512 + 8 * C.lane + (qq & 1) * 4; const f32x4 gg = *(const f32x4*)(g + c), sh = *(const f32x4*)(m + c), sc = *(const f32x4*)(m + DM + c);
                    f32x4 gt = {0.f, 0.f, 0.f, 0.f}; if (layer != 0) gt = *(const f32x4*)(m - MODLD + 5 * DM + c);
#pragma unroll
                    for (int j = 0; j < 4; ++j) { Av[qq * 4 + j] = gg[j] * (1.0f + sc[j]); Sv[qq * 4 + j] = sh[j]; Gv[qq * 4 + j] = gt[j]; } } }
            float v[16], h[16];
            if (layer == 0) { const f32x4 f0 = __builtin_bit_cast(f32x4, R[q].a0), f1 = __builtin_bit_cast(f32x4, R[q].a1), f2 = __builtin_bit_cast(f32x4, R[q].a2), f3 = __builtin_bit_cast(f32x4, R[q].a3);
                v[0] = f0[0]; v[1] = f0[1]; v[2] = f0[2]; v[3] = f0[3]; v[4] = f1[0]; v[5] = f1[1]; v[6] = f1[2]; v[7] = f1[3];
                v[8] = f2[0]; v[9] = f2[1]; v[10] = f2[2]; v[11] = f2[3]; v[12] = f3[0]; v[13] = f3[1]; v[14] = f3[2]; v[15] = f3[3];
            } else { float t[8], yf[8]; unpack8(R[q].a0, t); unpack8(R[q].y0, yf);
#pragma unroll
                for (int j = 0; j < 8; ++j) v[j] = t[j] + Gv[j] * yf[j];
                unpack8(R[q].a1, t); unpack8(R[q].y1, yf);
#pragma unroll
                for (int j = 0; j < 8; ++j) v[8 + j] = t[j] + Gv[8 + j] * yf[j];
                store_h_wt(XB + (size_t)r * DM, C.lane, v); }
            float ss = 0.f;
#pragma unroll
            for (int j = 0; j < 16; ++j) ss += v[j] * v[j];
            ss = wave_sum(ss, C.lane);
            const float rstd = 1.0f / sqrtf(ss * (1.0f / 1024.0f) + EPS);
#pragma unroll
            for (int j = 0; j < 16; ++j) h[j] = v[j] * rstd * Av[j] + Sv[j];
            store_h_wt(H + (size_t)r * DM, C.lane, h); store_h8(C.ws + WS_H8 + (size_t)r * DM, C.lane, h); asm volatile("" ::: "memory"); }
    }
}
__device__ __forceinline__ void phase_final(const Ctx& C, float* __restrict__ out, const bf16_t* __restrict__ XB) {
    const bool poison = __hip_atomic_load((const unsigned*)(C.ws + WS_BAR + 49152), __ATOMIC_RELAXED, __HIP_MEMORY_SCOPE_AGENT) != 0u;
    const float* __restrict__ MOD = (const float*)(C.ws + WS_MOD) + (size_t)(DEPTH - 1) * MODLD; const bf16_t* __restrict__ Y = (const bf16_t*)(C.ws + WS_MIX + MIX_OUT);
    const int rows_per = NB * LAT / C.G, c0 = (C.tid & 127) * 8, b = (C.bid * rows_per) / LAT;
    const float* gt = MOD + (size_t)b * 6144 + 5 * DM + c0; const f32x4 g0 = *(const f32x4*)gt, g1 = *(const f32x4*)(gt + 4);
#pragma unroll 4
    for (int k = (C.tid >> 7); k < rows_per; k += 4) {
        const int lr = C.bid * rows_per + k, t = lr - b * LAT, r = b * TPB + CTX + t;
        float* xp = out + (size_t)lr * DM + c0; float yf[8], xf[8]; unpack8(*(const u32x4*)(Y + (size_t)r * DM + c0), yf); unpack8(*(const u32x4*)(XB + (size_t)r * DM + c0), xf);
        *(f32x4*)xp = (f32x4){xf[0] + g0[0] * yf[0], xf[1] + g0[1] * yf[1], xf[2] + g0[2] * yf[2], xf[3] + g0[3] * yf[3]};
        *(f32x4*)(xp + 4) = (f32x4){xf[4] + g1[0] * yf[4], xf[5] + g1[1] * yf[5], xf[6] + g1[2] * yf[6], xf[7] + g1[3] * yf[7]};
        if (poison) { const float qn = __builtin_nanf(""); *(f32x4*)xp = (f32x4){qn, qn, qn, qn}; *(f32x4*)(xp + 4) = (f32x4){qn, qn, qn, qn}; }
    }
}

__device__ __forceinline__ void seq_pos(int r, int& t, int& L) { const int tt = r % TPB; if (tt < CTX) { t = tt; L = CTX; } else { t = tt - CTX; L = LAT; } }
__device__ __forceinline__ void phase_conv(const Ctx& C, int layer, int half) {
    const bf16_t* Pg = (const bf16_t*)(C.ws + WS_MIX + MIX_P); unsigned char* BR = C.ws + WS_BR; const float* cw = C.in(I_CONVW) + layer * 3 * 512;
    float cw0[8], cw1[8], cw2[8];
    { const int c0 = (C.tid & 63) * 8;
#pragma unroll
      for (int j = 0; j < 8; ++j) { cw0[j] = cw[c0 + j]; cw1[j] = cw[512 + c0 + j]; cw2[j] = cw[1024 + c0 + j]; } }
    for (int it = C.bid * 512 + C.tid; it < (HROWS / 2) * 64; it += C.G * 512) {
        const int lr = (it >> 6) * 2, c0 = (it & 63) * 8, r = half * HROWS + lr; int t, L; seq_pos(r, t, L);
        const bf16_t* p = Pg + (size_t)lr * PLD;
        const bool hasp = t > 0, hasn = t + 2 < L;
        const bf16_t* pp = hasp ? p - PLD : p; const bf16_t* pn = hasn ? p + 2 * PLD : p;
        const u32x4 g0 = *(const u32x4*)(p + 512 + c0), g1 = *(const u32x4*)(p + PLD + 512 + c0);
        const u32x4 a0 = *(const u32x4*)(pp + 1024 + c0), b0 = *(const u32x4*)(pp + 1536 + c0), a1 = *(const u32x4*)(p + 1024 + c0), b1 = *(const u32x4*)(p + 1536 + c0);
        const u32x4 a2 = *(const u32x4*)(p + PLD + 1024 + c0), b2 = *(const u32x4*)(p + PLD + 1536 + c0), a3 = *(const u32x4*)(pn + 1024 + c0), b3 = *(const u32x4*)(pn + 1536 + c0);
        float x0[8], x1[8], x2[8], x3[8], fa[8], fb[8], gb0[8], gb1[8];
        unpack8(a0, fa); unpack8(b0, fb);
#pragma unroll
        for (int j = 0; j < 8; ++j) x0[j] = hasp ? fa[j] * fb[j] : 0.f;
        unpack8(a1, fa); unpack8(b1, fb);
#pragma unroll
        for (int j = 0; j < 8; ++j) x1[j] = fa[j] * fb[j];
        unpack8(a2, fa); unpack8(b2, fb);
#pragma unroll
        for (int j = 0; j < 8; ++j) x2[j] = fa[j] * fb[j];
        unpack8(a3, fa); unpack8(b3, fb);
#pragma unroll
        for (int j = 0; j < 8; ++j) x3[j] = hasn ? fa[j] * fb[j] : 0.f;
        unpack8(g0, gb0); unpack8(g1, gb1);
        float o0[8], o1[8];
#pragma unroll
        for (int j = 0; j < 8; ++j) { const float w0 = cw0[j], w1 = cw1[j], w2 = cw2[j];
            o0[j] = gb0[j] * (w0 * x0[j] + w1 * x1[j] + w2 * x2[j]); o1[j] = gb1[j] * (w0 * x1[j] + w1 * x2[j] + w2 * x3[j]); }
        u32x2 wa, wb; wa.x = pk4_fp8(o0[0], o0[1], o0[2], o0[3]); wa.y = pk4_fp8(o0[4], o0[5], o0[6], o0[7]); wb.x = pk4_fp8(o1[0], o1[1], o1[2], o1[3]); wb.y = pk4_fp8(o1[4], o1[5], o1[6], o1[7]);
        const bool odd = it & 1; const unsigned sx = odd ? wa.x : wb.x, sy = odd ? wa.y : wb.y;
        const unsigned rx = (unsigned)__builtin_amdgcn_update_dpp(0, (int)sx, 0xB1, 0xf, 0xf, false), ry = (unsigned)__builtin_amdgcn_update_dpp(0, (int)sy, 0xB1, 0xf, 0xf, false);
        const u32x4 w = odd ? (u32x4){rx, ry, wb.x, wb.y} : (u32x4){wa.x, wa.y, rx, ry};
        *(u32x4*)(BR + (size_t)(r + (odd ? 1 : 0)) * 2048 + 512 + (c0 & ~15)) = w;
    }
}
template <int GI, int R>
__device__ __forceinline__ void pool_rows(const bf16_t* Pg, unsigned char* BR, int half, int lr, int li) {
    constexpr int W = 2 << GI, H = W / 2, NR = R + W - 1;
    const int c0 = GI * 128 + (li & 15) * 8, r = half * HROWS + lr; int t, L; seq_pos(r, t, L);
    const unsigned char* pb = (const unsigned char*)Pg; const unsigned ob = (unsigned)(2048 + c0) * 2u;
    u32x4 v[NR];
#pragma unroll
    for (int k = 0; k < NR; ++k) { const int q = t - H + k; const int qc = min(max(q, 0), L - 1); v[k] = *(const u32x4*)(pb + ((unsigned)(lr + qc - t) * (unsigned)(PLD * 2) + ob)); }
    float s8[8], f[8];
#pragma unroll
    for (int j = 0; j < 8; ++j) s8[j] = 0.f;
#pragma unroll
    for (int k = 0; k < W; ++k) { const int q = t - H + k; const float wt = (q >= 0 && q < L) ? 1.f : 0.f; unpack8(v[k], f);
#pragma unroll
        for (int j = 0; j < 8; ++j) s8[j] += wt * f[j]; }
    unsigned wx[R], wy[R];
#pragma unroll
    for (int i = 0; i < R; ++i) {
        if (i > 0) {
            const int ql = t - H + i - 1, qe = t + H + i - 1; const float wl = (ql >= 0) ? -1.f : 0.f, we = (qe < L) ? 1.f : 0.f;
            unpack8(v[i - 1], f);
#pragma unroll
            for (int j = 0; j < 8; ++j) s8[j] += wl * f[j];
            unpack8(v[i + W - 1], f);
#pragma unroll
            for (int j = 0; j < 8; ++j) s8[j] += we * f[j];
        }
        const int ti = t + i, lo = max(ti - H, 0), hi = min(ti + H, L); const float inv = __builtin_amdgcn_rcpf((float)(hi - lo));
        unpack8(v[i + H], f);
        float o[8];
#pragma unroll
        for (int j = 0; j < 8; ++j) o[j] = s8[j] * inv - f[j];
        wx[i] = pk4_fp8(o[0], o[1], o[2], o[3]); wy[i] = pk4_fp8(o[4], o[5], o[6], o[7]);
    }
    const bool odd = li & 1; unsigned char* dst = BR + (size_t)(r + (odd ? R / 2 : 0)) * 2048 + 1024 + (c0 & ~15);
#pragma unroll
    for (int i = 0; i < R / 2; ++i) {
        const unsigned sx = odd ? wx[i] : wx[R / 2 + i], sy = odd ? wy[i] : wy[R / 2 + i];
        const unsigned rx = (unsigned)__builtin_amdgcn_update_dpp(0, (int)sx, 0xB1, 0xf, 0xf, false), ry = (unsigned)__builtin_amdgcn_update_dpp(0, (int)sy, 0xB1, 0xf, 0xf, false);
        *(u32x4*)(dst + (size_t)i * 2048) = odd ? (u32x4){rx, ry, wx[R / 2 + i], wy[R / 2 + i]} : (u32x4){wx[i], wy[i], rx, ry};
    }
}
template <int GI>
__device__ __forceinline__ void pool_item(const bf16_t* Pg, unsigned char* BR, int half, int li) {
    const int lr = (li >> 4) * 8;
    if constexpr (GI < 3) pool_rows<GI, 8>(Pg, BR, half, lr, li);
    else { pool_rows<GI, 4>(Pg, BR, half, lr, li); asm volatile("" ::: "memory"); pool_rows<GI, 4>(Pg, BR, half, lr + 4, li); }
}
__device__ __forceinline__ void phase_pool(const Ctx& C, int half) {
    const bf16_t* Pg = (const bf16_t*)(C.ws + WS_MIX + MIX_P); unsigned char* BR = C.ws + WS_BR;
    constexpr int NW = (HROWS / 8) * 16 / 64;
    for (int wi = C.bid + C.G * C.wave; wi < 4 * NW; wi += C.G * 8) {
        const int g = __builtin_amdgcn_readfirstlane(wi / NW), li = (wi - g * NW) * 64 + C.lane;
        if (g == 0) pool_item<0>(Pg, BR, half, li); else if (g == 1) pool_item<1>(Pg, BR, half, li); else if (g == 2) pool_item<2>(Pg, BR, half, li); else pool_item<3>(Pg, BR, half, li);
    }
}
__device__ __forceinline__ void phase_sgu(const Ctx& C, int layer, int half) {
    const bf16_t* Pg = (const bf16_t*)(C.ws + WS_MIX + MIX_P); unsigned char* BR = C.ws + WS_BR; const float* SS = (const float*)(C.ws + WS_SS);
    const bf16_t* Wg = (const bf16_t*)(C.ws + WS_W + W_SGU); const float* gain = C.in(I_SGUNG) + layer * 512; const float* bias = C.in(I_SGUB) + layer * 512;
    const int fr = C.lane & 15, fq = C.lane >> 4;
    int par = 0;
    __syncthreads();
    for (int unit = C.bid; unit < (HROWS / 128) * 4; unit += C.G, par ^= 1) {
        const int ch = unit >> 2, g = unit & 3, lr0 = ch * 128;
        LAS unsigned char* vT = C.lds + par * 34816;
        LAS float* rs = (LAS float*)(C.lds + 69632) + par * 128;
        u32x4 va[2], vb[2];
#pragma unroll
        for (int j = 0; j < 2; ++j) { const int id = C.tid + 512 * j, qp = id >> 4, cc = (id & 15) * 8; const bf16_t* src = Pg + (size_t)(lr0 + 2 * qp) * PLD + 3072 + g * 128 + cc;
            va[j] = *(const u32x4*)src; vb[j] = *(const u32x4*)(src + PLD); }
        const int p = C.wave * 16 + fr;
        bf16x8 af[4];
#pragma unroll
        for (int ks = 0; ks < 4; ++ks) af[ks] = *(const bf16x8*)(Wg + ((size_t)g * 128 + p) * 128 + ks * 32 + fq * 8);
        u32x4 uq[4];
#pragma unroll
        for (int i = 0; i < 4; ++i) uq[i] = *(const u32x4*)(Pg + (size_t)(lr0 + p) * PLD + 2560 + g * 128 + fq * 32 + i * 8);
        const float bp = bias[g * 128 + p];
        if (C.tid < 128) { const f32x4 s0 = *(const f32x4*)(SS + (size_t)(lr0 + C.tid) * 8), s1 = *(const f32x4*)(SS + (size_t)(lr0 + C.tid) * 8 + 4);
            rs[C.tid] = 1.0f / sqrtf((((s0[0] + s0[1]) + (s0[2] + s0[3])) + ((s1[0] + s1[1]) + (s1[2] + s1[3]))) * (1.0f / 512.0f) + EPS); }
        __syncthreads();
#pragma unroll
        for (int j = 0; j < 2; ++j) { const int id = C.tid + 512 * j, qp = id >> 4, cc = (id & 15) * 8; const float r0 = rs[2 * qp], r1 = rs[2 * qp + 1]; float f0[8], f1[8];
            unpack8(va[j], f0); unpack8(vb[j], f1);
            const f32x4 g0 = *(const f32x4*)(gain + g * 128 + cc), g1 = *(const f32x4*)(gain + g * 128 + cc + 4);
            const float gn[8] = {g0[0], g0[1], g0[2], g0[3], g1[0], g1[1], g1[2], g1[3]};
            LAS unsigned char* wp = vT + (((qp >> 2) ^ ((cc >> 3) & 15)) * 16 + (qp & 3) * 4);
#pragma unroll
            for (int e = 0; e < 8; ++e) *(LAS unsigned*)(wp + (cc + e) * 272) = pk2(f0[e] * r0 * gn[e], f1[e] * r1 * gn[e]); }
        __syncthreads();
        const int r = half * HROWS + lr0 + p;
        unsigned ob[8];
#pragma unroll
        for (int ct = 0; ct < 8; ++ct) {
            f32x4 acc = {0.f, 0.f, 0.f, 0.f}; const int c = (fr >> 2) * 32 + ct * 4 + (fr & 3);
#pragma unroll
            for (int ks = 0; ks < 4; ++ks) { const bf16x8 bfr = *(const LAS bf16x8*)(vT + c * 272 + (((ks * 4 + fq) ^ ((c >> 3) & 15)) * 16));
                acc = __builtin_amdgcn_mfma_f32_16x16x32_bf16(bfr, af[ks], acc, 0, 0, 0); }
            const unsigned ux = uq[ct >> 1][(ct & 1) * 2], uy = uq[ct >> 1][(ct & 1) * 2 + 1];
            ob[ct] = pk4_fp8(bflo(ux) * (acc[0] + bp), bfhi(ux) * (acc[1] + bp), bflo(uy) * (acc[2] + bp), bfhi(uy) * (acc[3] + bp));
        }
        { unsigned char* op = BR + (size_t)r * 2048 + 1536 + g * 128 + fq * 32;
          *(u32x4*)op = (u32x4){ob[0], ob[1], ob[2], ob[3]}; *(u32x4*)(op + 16) = (u32x4){ob[4], ob[5], ob[6], ob[7]}; }
    }
}

namespace att {
constexpr int SHM_V = 8192, SHM_K = 16384;
#define KSWZ(row, colB) ((row) * 256 + ((colB) ^ (((row) & 15) << 4)))
#define SBAR() __builtin_amdgcn_sched_barrier(0)
__device__ __forceinline__ int crow(int r, int hi) { return (r & 3) + 8 * (r >> 2) + 4 * hi; }
__device__ __forceinline__ void expA(f32x16& p0) {
#pragma unroll
    for (int r = 0; r < 16; ++r) p0[r] = __builtin_amdgcn_exp2f(p0[r]);
}
__device__ __forceinline__ void finishSM(f32x16& p0, f32x16& p1, float& l_reg, bf16x8& pa0, bf16x8& pa1, bf16x8& pa2, bf16x8& pa3) {
#pragma unroll
    for (int r = 0; r < 16; ++r) p1[r] = __builtin_amdgcn_exp2f(p1[r]);
    f32x2 s2 = {0.f, 0.f};
#pragma unroll
    for (int r = 0; r < 8; ++r) s2 += (f32x2){p0[2 * r], p0[2 * r + 1]};
#pragma unroll
    for (int r = 0; r < 8; ++r) s2 += (f32x2){p1[2 * r], p1[2 * r + 1]};
    float ps = s2.x + s2.y;
    { auto rr = __builtin_amdgcn_permlane32_swap(__float_as_uint(ps), __float_as_uint(ps), false, false); ps = __uint_as_float(rr[0]) + __uint_as_float(rr[1]); }
    l_reg += ps;
#define PK4(P, BASE, OUT) do { unsigned a0 = pk2(P[BASE + 0], P[BASE + 1]), a1 = pk2(P[BASE + 2], P[BASE + 3]);   \
    unsigned b0 = pk2(P[BASE + 4], P[BASE + 5]), b1 = pk2(P[BASE + 6], P[BASE + 7]);                              \
    auto r0 = __builtin_amdgcn_permlane32_swap(a0, b0, false, false); auto r1 = __builtin_amdgcn_permlane32_swap(a1, b1, false, false); \
    u32x4 w = {r0[0], r1[0], r0[1], r1[1]}; OUT = __builtin_bit_cast(bf16x8, w); } while (0)
    PK4(p0, 0, pa0); PK4(p0, 8, pa1); PK4(p1, 0, pa2); PK4(p1, 8, pa3);
#undef PK4
}
__device__ __forceinline__ void qkt(f32x16& p0, f32x16& p1, const LAS unsigned char* Ks, const bf16x8* qr, int r32, int hi, float negc) {
#pragma unroll
    for (int r = 0; r < 16; ++r) { p0[r] = negc; p1[r] = negc; }
#pragma unroll
    for (int d0 = 0; d0 < 6; ++d0) { const int cb = (d0 * 16 + hi * 8) * 2;
        const bf16x8 b0 = *(const LAS bf16x8*)(Ks + KSWZ(r32, cb));
        const bf16x8 b1 = *(const LAS bf16x8*)(Ks + KSWZ(32 + r32, cb));
        p0 = __builtin_amdgcn_mfma_f32_32x32x16_bf16(b0, qr[d0], p0, 0, 0, 0);
        p1 = __builtin_amdgcn_mfma_f32_32x32x16_bf16(b1, qr[d0], p1, 0, 0, 0); }
}
__device__ __forceinline__ int v_st(int k, int c) { const int kk = (k & ~0xC) | ((k & 4) << 1) | ((k & 8) >> 1); return ((kk >> 3) * 2 + (c >> 5)) * 512 + ((kk & 7) * 32 + (c & 31)) * 2; }
__device__ __forceinline__ int v_rd_base(int lane) { return ((lane & 3) << 3) | (((lane >> 2) & 3) << 6) | (((lane >> 4) & 1) << 5) | (((lane >> 5) & 1) << 8); }
constexpr int v_rd_off(int d0, int ks, int half) { return d0 * 512 + ks * 2048 + half * 1024; }
template <int OFF> __device__ __forceinline__ s16x4 tr_read(int vb) { s16x4 r; asm volatile("ds_read_b64_tr_b16 %0, %1 offset:%2" : "=&v"(r) : "v"(vb), "i"(OFF) : "memory"); return r; }
template <int D0> __device__ __forceinline__ void pv_one(f32x16& od, int vb, bf16x8 pa0, bf16x8 pa1, bf16x8 pa2, bf16x8 pa3) {
    const s16x4 l0 = tr_read<v_rd_off(D0, 0, 0)>(vb), h0 = tr_read<v_rd_off(D0, 0, 1)>(vb), l1 = tr_read<v_rd_off(D0, 1, 0)>(vb), h1 = tr_read<v_rd_off(D0, 1, 1)>(vb);
    const s16x4 l2 = tr_read<v_rd_off(D0, 2, 0)>(vb), h2 = tr_read<v_rd_off(D0, 2, 1)>(vb), l3 = tr_read<v_rd_off(D0, 3, 0)>(vb), h3 = tr_read<v_rd_off(D0, 3, 1)>(vb);
    asm volatile("s_waitcnt lgkmcnt(0)" ::: "memory"); SBAR();
#define PKV(L, H) (bf16x8){L[0], L[1], L[2], L[3], H[0], H[1], H[2], H[3]}
    od = __builtin_amdgcn_mfma_f32_32x32x16_bf16(pa0, PKV(l0, h0), od, 0, 0, 0);
    od = __builtin_amdgcn_mfma_f32_32x32x16_bf16(pa1, PKV(l1, h1), od, 0, 0, 0);
    od = __builtin_amdgcn_mfma_f32_32x32x16_bf16(pa2, PKV(l2, h2), od, 0, 0, 0);
    od = __builtin_amdgcn_mfma_f32_32x32x16_bf16(pa3, PKV(l3, h3), od, 0, 0, 0);
#undef PKV
}
__device__ __forceinline__ void attn_body(const bf16_t* __restrict__ Qb, const bf16_t* __restrict__ Kh, const bf16_t* __restrict__ Vh, unsigned char* __restrict__ Ob, int seq, LAS unsigned char* lds, const int tid, const float negc,
                                          const float* __restrict__ rqrow, const float* __restrict__ qgain, const float* __restrict__ rope_cs, int qpos) {
    const int wid = tid >> 6, lane = tid & 63, r32 = lane & 31, hi = lane >> 5;
    LAS unsigned char* V_lds = lds; LAS unsigned char* K_lds = lds + 2 * SHM_V;
    LAS float* wsf = (LAS float*)(lds + 2 * SHM_V + 2 * SHM_K) + wid * 64; LAS float* li_l = wsf;
    float l_reg = 0; f32x16 o[2] = {}; bf16x8 qr[6];
    const int sr = tid >> 4, sc = (tid & 15) * 8, vr = tid >> 3, vc = (tid & 7) * 8, vst = v_st(vr, vc);
    const int vb0 = (int)(unsigned)(uintptr_t)V_lds + v_rd_base(lane);
    struct { bf16x8 vs, ks0, ks1; } sr_[2];
    unsigned kof = (unsigned)(sr * 256 + sc * 2), vof = (unsigned)(vr * 2048 + vc * 2);
    asm volatile("" : "+v"(kof), "+v"(vof));
#define SLOAD(i, k0) do { const char* kb_ = (const char*)Kh + (size_t)(k0) * 256; const char* vb_ = (const char*)Vh + (size_t)(k0) * 2048; \
    sr_[i].vs = *(const bf16x8*)(vb_ + vof); sr_[i].ks0 = *(const bf16x8*)(kb_ + kof); sr_[i].ks1 = *(const bf16x8*)(kb_ + kof + 8192u); } while (0)
#define SWRITE(b, i) do { *(LAS bf16x8*)(V_lds + (b) * SHM_V + vst) = sr_[i].vs; const int kc = sc * 2; \
    *(LAS bf16x8*)(K_lds + (b) * SHM_K + KSWZ(sr, kc)) = sr_[i].ks0; *(LAS bf16x8*)(K_lds + (b) * SHM_K + KSWZ(32 + sr, kc)) = sr_[i].ks1; } while (0)
#define SWAIT() asm volatile("s_waitcnt vmcnt(3)" ::: "memory")
    constexpr int SE = 0, SO = 1;
    SLOAD(SE, 0); SLOAD(SO, 64); SBAR();
    {
        const bf16_t* Qw = Qb + (size_t)(wid * 32 + r32) * 768 + hi * 8;
        float qf[6][8]; float rq; { const float* sa = rqrow + (size_t)(wid * 32 + r32) * 16; const f32x4 s1 = *(const f32x4*)(sa + 4), s2 = *(const f32x4*)(sa + 8), s3 = *(const f32x4*)(sa + 12);
            rq = 1.0f / sqrtf((((s1[1] + s1[2]) + (s1[3] + s2[0])) + ((s2[1] + s2[2]) + (s2[3] + s3[0])) + ((s3[1] + s3[2]) + s3[3])) * (1.0f / 256.0f) + EPS); }
        float ss = 0.f;
#pragma unroll
        for (int d0 = 0; d0 < 6; ++d0) { float f[8]; unpack8(*(const u32x4*)(Qw + d0 * 16), f);
#pragma unroll
            for (int e = 0; e < 8; ++e) { qf[d0][e] = f[e] * rq; ss += qf[d0][e] * qf[d0][e]; } }
        { auto rr = __builtin_amdgcn_permlane32_swap(__float_as_uint(ss), __float_as_uint(ss), false, false); ss = __uint_as_float(rr[0]) + __uint_as_float(rr[1]); }
        const float rn = QSCALE / sqrtf(ss * (1.0f / 96.0f) + EPS);
#pragma unroll
        for (int d0 = 0; d0 < 6; ++d0)
#pragma unroll
            for (int e = 0; e < 8; ++e) qf[d0][e] *= rn * qgain[d0 * 16 + hi * 8 + e];
        if (qpos >= 0) { const float* rc = rope_cs + (size_t)(qpos + wid * 32 + r32) * 16 + hi * 8;
#pragma unroll
            for (int e = 0; e < 8; ++e) { const float c = rc[e], sn = rc[32768 + e], r1 = qf[4][e], r2 = qf[5][e]; qf[4][e] = r1 * c - r2 * sn; qf[5][e] = r1 * sn + r2 * c; } }
#pragma unroll
        for (int d0 = 0; d0 < 6; ++d0) { u32x4 w; w.x = pk2(qf[d0][0], qf[d0][1]); w.y = pk2(qf[d0][2], qf[d0][3]); w.z = pk2(qf[d0][4], qf[d0][5]); w.w = pk2(qf[d0][6], qf[d0][7]); qr[d0] = __builtin_bit_cast(bf16x8, w); }
    }
    f32x16 pA0, pA1, pB0, pB1; bf16x8 pa0, pa1, pa2, pa3; const int NT = seq / 64;
    SBAR(); asm volatile("s_waitcnt vmcnt(0)" ::: "memory"); SWRITE(0, SE); SWRITE(1, SO);
    SLOAD(SE, (2 < NT ? 2 : NT - 1) * 64); __syncthreads();
    if (__builtin_amdgcn_readfirstlane(wid) >= 4) __builtin_amdgcn_s_setprio(1);
    qkt(pA0, pA1, K_lds, qr, r32, hi, negc); expA(pA0);
    for (int j = 1; j + 1 < NT; j += 2) {
        SBAR(); qkt(pB0, pB1, K_lds + SHM_K, qr, r32, hi, negc);
        finishSM(pA0, pA1, l_reg, pa0, pa1, pa2, pa3); SBAR();
        SLOAD(SO, (j + 2) * 64); SBAR();
        pv_one<0>(o[0], vb0, pa0, pa1, pa2, pa3); pv_one<1>(o[1], vb0, pa0, pa1, pa2, pa3); expA(pB0);
        __syncthreads(); SWAIT(); SWRITE(0, SE);
        __syncthreads();
        SBAR(); qkt(pA0, pA1, K_lds, qr, r32, hi, negc);
        finishSM(pB0, pB1, l_reg, pa0, pa1, pa2, pa3); SBAR();
        SLOAD(SE, (j + 3 < NT ? j + 3 : NT - 1) * 64); SBAR();
        pv_one<0>(o[0], vb0 + SHM_V, pa0, pa1, pa2, pa3); pv_one<1>(o[1], vb0 + SHM_V, pa0, pa1, pa2, pa3); expA(pA0);
        __syncthreads(); SWAIT(); SWRITE(1, SO);
        __syncthreads();
    }
    SBAR(); qkt(pB0, pB1, K_lds + SHM_K, qr, r32, hi, negc);
    finishSM(pA0, pA1, l_reg, pa0, pa1, pa2, pa3); SBAR();
    pv_one<0>(o[0], vb0, pa0, pa1, pa2, pa3); pv_one<1>(o[1], vb0, pa0, pa1, pa2, pa3); expA(pB0);
    __syncthreads();
    finishSM(pB0, pB1, l_reg, pa0, pa1, pa2, pa3); SBAR();
    pv_one<0>(o[0], vb0 + SHM_V, pa0, pa1, pa2, pa3); pv_one<1>(o[1], vb0 + SHM_V, pa0, pa1, pa2, pa3);
    if (hi == 0) li_l[r32] = l_reg; asm volatile("s_waitcnt lgkmcnt(0)" ::: "memory");
    float rli[16];
#pragma unroll
    for (int r = 0; r < 16; ++r) rli[r] = __builtin_amdgcn_rcpf(li_l[crow(r, hi)]);
    __builtin_amdgcn_s_setprio(0);
    unsigned char* Ow = Ob + (size_t)(wid * 32) * 2048 + (r32 & ~3);
    const int q4 = r32 & 3;
    const unsigned sel1 = (q4 & 1) ? 0x03070105u : 0x06020400u, sel2 = (q4 & 2) ? 0x03020706u : 0x05040100u;
#pragma unroll
    for (int d0 = 0; d0 < 2; ++d0)
#pragma unroll
        for (int i = 0; i < 4; ++i) {
            const unsigned w = pk4_fp8(o[d0][4 * i] * rli[4 * i], o[d0][4 * i + 1] * rli[4 * i + 1], o[d0][4 * i + 2] * rli[4 * i + 2], o[d0][4 * i + 3] * rli[4 * i + 3]);
            const unsigned p1 = (unsigned)__builtin_amdgcn_update_dpp(0, (int)w, 0xB1, 0xf, 0xf, false);
            const unsigned t1 = __builtin_amdgcn_perm(p1, w, sel1);
            const unsigned p2 = (unsigned)__builtin_amdgcn_update_dpp(0, (int)t1, 0x4E, 0xf, 0xf, false);
            const unsigned t2 = __builtin_amdgcn_perm(p2, t1, sel2);
            *(unsigned*)(Ow + (size_t)(q4 + 8 * i + 4 * hi) * 2048 + d0 * 32) = t2; }
#undef SLOAD
#undef SWRITE
#undef SWAIT
}
}
__device__ __forceinline__ void phase_attn(const Ctx& C, int layer, int half, bool do_ctx) {
    float gq = 0.f, gk = 0.f; { const float* qng = C.in(I_QNG) + layer * 96; const float* kng = C.in(I_KNG) + layer * 96; for (int e = 0; e < 96; ++e) { gq = fmaxf(gq, fabsf(qng[e])); gk = fmaxf(gk, fabsf(kng[e])); } }
    const float negc = -fminf(96.0f * gq * gk * QSCALE * 1.0001f, 60.0f);
    const unsigned char* mix = C.ws + WS_MIX;
    const bf16_t* QR = (const bf16_t*)(mix + MIX_QRAW); const float* RQ = (const float*)(mix + MIX_Q);        const bf16_t* K = (const bf16_t*)(mix + MIX_K); const bf16_t* KVR = (const bf16_t*)(mix + MIX_KVRAW); unsigned char* BR = C.ws + WS_BR;
    const float* qng = C.in(I_QNG) + layer * 96; const float* RC = (const float*)(C.ws + WS_ROPE);
    const int vcu = (C.G % 8 == 0) ? (C.bid % 8) * (C.G / 8) + C.bid / 8 : C.bid;
    const int nlat = 8 * NH * 8, nunits = nlat + (do_ctx ? 8 * NH : 0);
    for (int u = vcu; u < nunits; u += C.G) {
        int bh, t0, seq;
        if (u < nlat) { bh = u >> 3; t0 = CTX + (u & 7) * 256; seq = TPB; } else { bh = u - nlat; t0 = 0; seq = CTX; }
        const int bl = bh >> 3, h = bh & 7;
        __syncthreads();
        att::attn_body(QR + ((size_t)bl * TPB + t0) * 768 + h * 96, K + (size_t)bh * TPB * 128, KVR + (size_t)bl * TPB * 1024 + h * 128 + 64,
                       BR + ((size_t)(half * HROWS + bl * TPB + t0)) * 2048 + h * 64, seq, C.lds, C.tid, negc, RQ + ((size_t)half * HROWS + (size_t)bl * TPB + t0) * 16, qng, RC, t0 >= CTX ? t0 - CTX : -1);
    }
}

struct SchedQKV {
    static constexpr bool GATHER = false, FP8 = false;
    const char* P; const char* WUQ; const char* WUKV; int G, c;
    __device__ __forceinline__ bool next(int i, Unit& u) const { const int L = i * G + c; if (L >= HPAN * 7) return false; u.pm = L / 7; const int j = L - u.pm * 7; u.aux = (j + 5) >> 3; u.pn = j - 3 * u.aux; return true; }
    __device__ __forceinline__ void setup(const Unit& u, const char*& a, const char*& b0, const char*& b1, unsigned& lda, unsigned& ldb, int& nt, int& nt0) const {
        a = P + (size_t)u.pm * 256 * (PLD * 2) + (u.aux ? 0 : 320); b0 = (u.aux ? WUKV : WUQ) + (size_t)u.pn * 256 * 512; b1 = b0; lda = PLD * 2; ldb = 512u; nt = 4 - 2 * u.aux; nt0 = nt; }
    __device__ __forceinline__ unsigned rowoff(const Unit&, int) const { return 0u; }
    __device__ __forceinline__ bool keep_acc(const Unit&) const { return false; }
};
struct EpiQKV {
    static constexpr bool PERM = true;
    bf16_t* QR; bf16_t* KVR; bf16_t* Ko; const bf16_t* Pg; const float* SA; const float* kng; const float* RC;
    __device__ __forceinline__ void operator()(f32x4 (&acc)[2][2][4][2], const Unit& u, int wr, int wc, int fr, int fq) const {
        if (!u.aux) {
            const int row0 = u.pm * 256 + wr * 64 + fr, col0 = u.pn * 256 + wc * 32 + 8 * fq;
#pragma unroll
            for (int ai = 0; ai < 2; ++ai)
#pragma unroll
                for (int m = 0; m < 4; ++m) { bf16_t* rowp = QR + (size_t)(row0 + ai * 128 + m * 16) * 768 + col0;
#pragma unroll
                    for (int bj = 0; bj < 2; ++bj) { const f32x4 v0 = acc[ai][bj][m][0], v1 = acc[ai][bj][m][1];
                        u32x4 w; w.x = pk2(v0[0], v0[1]); w.y = pk2(v0[2], v0[3]); w.z = pk2(v1[0], v1[1]); w.w = pk2(v1[2], v1[3]);
                        *(u32x4*)(rowp + bj * 128) = w; } }
            return;
        }
        const int h = 2 * u.pn + (wc >> 1), ln = fq * 16 + fr; const bool isv = (wc & 1) != 0;
        const int row0 = u.pm * 256 + wr * 64 + fr;
        if (isv) {
#pragma unroll
            for (int ai = 0; ai < 2; ++ai) { f32x4 st[4];
#pragma unroll
                for (int m = 0; m < 4; ++m) st[m] = *(const f32x4*)(SA + (size_t)(row0 + ai * 128 + m * 16) * 16);
#pragma unroll
                for (int m = 0; m < 4; ++m) { const int lr = row0 + ai * 128 + m * 16; const float rkv = 1.0f / sqrtf(((st[m][0] + st[m][1]) + (st[m][2] + st[m][3])) * (1.0f / 128.0f) + EPS);
                    bf16_t* vp = KVR + (size_t)lr * 1024 + h * 128 + 64 + 8 * fq;
#pragma unroll
                    for (int bj = 0; bj < 2; ++bj) { const f32x4 v0 = acc[ai][bj][m][0] * rkv, v1 = acc[ai][bj][m][1] * rkv;
                        u32x4 w; w.x = pk2(v0[0], v0[1]); w.y = pk2(v0[2], v0[3]); w.z = pk2(v1[0], v1[1]); w.w = pk2(v1[2], v1[3]);
                        *(u32x4*)(vp + bj * 32) = w; } } }
            return;
        }
        float gn[2][8]; f32x4 gr1 = *(const f32x4*)(kng + 64 + 4 * fq), gr2 = *(const f32x4*)(kng + 80 + 4 * fq);
#pragma unroll
        for (int bj = 0; bj < 2; ++bj) { const f32x4 a = *(const f32x4*)(kng + bj * 32 + 8 * fq), b2 = *(const f32x4*)(kng + bj * 32 + 8 * fq + 4);
            gn[bj][0] = a[0]; gn[bj][1] = a[1]; gn[bj][2] = a[2]; gn[bj][3] = a[3]; gn[bj][4] = b2[0]; gn[bj][5] = b2[1]; gn[bj][6] = b2[2]; gn[bj][7] = b2[3]; }
#pragma unroll
        for (int aim = 0; aim < 4; ++aim) { const int ai = aim >> 1, m0 = (aim & 1) * 2;
            f32x4 st[4], cs[4], sn[4]; float kr2[4]; u32x2 ka[4], kb[4];
#pragma unroll
            for (int m = m0; m < m0 + 2; ++m) { const int lr = row0 + ai * 128 + m * 16; const int bl = lr / TPB, tt = lr - bl * TPB; const int pos = tt >= CTX ? tt - CTX : 0;
                st[m] = *(const f32x4*)(SA + (size_t)lr * 16); kr2[m] = SA[(size_t)lr * 16 + 4];
                ka[m] = *(const u32x2*)(Pg + (size_t)lr * PLD + 128 + 4 * fq); kb[m] = *(const u32x2*)(Pg + (size_t)lr * PLD + 144 + 4 * fq);
                cs[m] = *(const f32x4*)(RC + pos * 16 + 4 * fq); sn[m] = *(const f32x4*)(RC + 32768 + pos * 16 + 4 * fq); }
#pragma unroll
            for (int m = m0; m < m0 + 2; ++m) { const int lr = row0 + ai * 128 + m * 16; const int bl = lr / TPB, tt = lr - bl * TPB; const bool lat = tt >= CTX;
                const float rkv = 1.0f / sqrtf(((st[m][0] + st[m][1]) + (st[m][2] + st[m][3])) * (1.0f / 128.0f) + EPS);
                float x[2][8], ssq = 0.f;
#pragma unroll
                for (int bj = 0; bj < 2; ++bj)
#pragma unroll
                    for (int e = 0; e < 4; ++e) { x[bj][e] = acc[ai][bj][m][0][e] * rkv; x[bj][4 + e] = acc[ai][bj][m][1][e] * rkv; ssq += x[bj][e] * x[bj][e] + x[bj][4 + e] * x[bj][4 + e]; }
                ssq += shx(ssq, 16, ln); ssq += shx(ssq, 32, ln);
                const float rn = 1.0f / sqrtf((ssq + kr2[m]) * (1.0f / 96.0f) + EPS);
                bf16_t* kd = Ko + (((size_t)bl * NH + h) * TPB + tt) * 128;
#pragma unroll
                for (int bj = 0; bj < 2; ++bj) { u32x4 w; w.x = pk2(x[bj][0] * rn * gn[bj][0], x[bj][1] * rn * gn[bj][1]); w.y = pk2(x[bj][2] * rn * gn[bj][2], x[bj][3] * rn * gn[bj][3]);
                    w.z = pk2(x[bj][4] * rn * gn[bj][4], x[bj][5] * rn * gn[bj][5]); w.w = pk2(x[bj][6] * rn * gn[bj][6], x[bj][7] * rn * gn[bj][7]);
                    *(u32x4*)(kd + bj * 32 + 8 * fq) = w; }
                float r1[4] = {bflo(ka[m].x) * rn * gr1[0], bfhi(ka[m].x) * rn * gr1[1], bflo(ka[m].y) * rn * gr1[2], bfhi(ka[m].y) * rn * gr1[3]};
                float r2[4] = {bflo(kb[m].x) * rn * gr2[0], bfhi(kb[m].x) * rn * gr2[1], bflo(kb[m].y) * rn * gr2[2], bfhi(kb[m].y) * rn * gr2[3]};
                float o1[4], o2[4];
#pragma unroll
                for (int i = 0; i < 4; ++i) { o1[i] = lat ? r1[i] * cs[m][i] - r2[i] * sn[m][i] : r1[i]; o2[i] = lat ? r1[i] * sn[m][i] + r2[i] * cs[m][i] : r2[i]; }
                u32x2 w1, w2; w1.x = pk2(o1[0], o1[1]); w1.y = pk2(o1[2], o1[3]); w2.x = pk2(o2[0], o2[1]); w2.y = pk2(o2[2], o2[3]);
                *(u32x2*)(kd + 64 + 4 * fq) = w1; *(u32x2*)(kd + 80 + 4 * fq) = w2; }
        }
    }
};
struct EpiGate8 {
    static constexpr bool PERM = true;
    static constexpr float ACC0 = -7.994353436858858f; static constexpr bool PERM16 = true;
    unsigned char* S8a; unsigned char* S8b;
    __device__ __forceinline__ void operator()(f32x4 (&acc)[2][2][4][2], const Unit& u, int wr, int wc, int fr, int fq) const {
        const int row0 = u.pm * 256 + wr * 64 + fr, col0 = u.pn * 256 + wc * 64 + 16 * fq; unsigned char* S8 = u.pm < HPAN ? S8a : S8b;
#pragma unroll
        for (int ai = 0; ai < 2; ++ai)
#pragma unroll
            for (int m = 0; m < 4; ++m) { unsigned char* rowp = S8 + (size_t)(row0 + ai * 128 + m * 16) * 4096 + col0;
                u32x4 w = {0u, 0u, 0u, 0u};
                f32x2 c2 = {1.0f / 255.0f, 1.0f / 255.0f}; asm volatile("" : "+v"(c2));
                const f32x4 c255 = __builtin_shufflevector(c2, c2, 0, 1, 0, 1), half4 = {0.5f, 0.5f, 0.5f, 0.5f};
#pragma unroll
                for (int bj = 0; bj < 2; ++bj) {
                    f32x4 e0, e1, r0, r1;
#pragma unroll
                    for (int e = 0; e < 4; ++e) { e0[e] = __builtin_amdgcn_fmed3f(__builtin_amdgcn_exp2f(acc[ai][bj][m][0][e]), 0.f, 1.f); e1[e] = __builtin_amdgcn_fmed3f(__builtin_amdgcn_exp2f(acc[ai][bj][m][1][e]), 0.f, 1.f); }
                    const f32x4 d0 = e0 + c255, d1 = e1 + c255;
#pragma unroll
                    for (int e = 0; e < 4; ++e) { r0[e] = __builtin_amdgcn_rcpf(d0[e]); r1[e] = __builtin_amdgcn_rcpf(d1[e]); }
                    const f32x4 g0 = r0 + half4, g1 = r1 + half4;
#pragma unroll
                    for (int e = 0; e < 4; ++e) {
                        if (bj == 0) { w.x = __builtin_amdgcn_cvt_pk_u8_f32(g0[e], e, w.x); w.y = __builtin_amdgcn_cvt_pk_u8_f32(g1[e], e, w.y); }
                        else { w.z = __builtin_amdgcn_cvt_pk_u8_f32(g0[e], e, w.z); w.w = __builtin_amdgcn_cvt_pk_u8_f32(g1[e], e, w.w); } } }
                *(u32x4*)rowp = w; }
    }
};
struct SchedP5 {
    static constexpr bool GATHER = false, FP8 = true;
    const char* BRp; const char* WB; int G, c, latent_only;
    __device__ __forceinline__ bool next(int i, Unit& u) const {
        if (i < 8) { u.aux = i & 3; if (!latent_only) return pg::grid_tile((long)(i >> 2) * G + c, NPAN, 4, u.pm, u.pn);
            const bool ok = pg::grid_tile((long)(i >> 2) * G + c, 128, 4, u.pm, u.pn); u.pm = (u.pm >> 3) * 9 + 1 + (u.pm & 7); return ok; }
        if (i >= 9 || latent_only) return false;
        u.aux = 4 + (c & 3); return pg::grid_tile(512 + (c >> 2), NPAN, 4, u.pm, u.pn); }
    __device__ __forceinline__ void setup(const Unit& u, const char*& a, const char*& b0, const char*& b1, unsigned& lda, unsigned& ldb, int& nt, int& nt0) const {
        const int n = u.aux & 3; a = BRp + (size_t)u.pm * 256 * 2048 + n * 512; b0 = WB + ((size_t)n * 1024 + u.pn * 256) * 512; nt = 4; lda = 2048u; ldb = 512u; b1 = b0; nt0 = nt; }
    __device__ __forceinline__ unsigned rowoff(const Unit&, int) const { return 0u; }
    __device__ __forceinline__ bool keep_acc(const Unit& u) const { return u.aux >= 1 && u.aux < 4; }
};
__device__ __forceinline__ void dec8(const u32x2 w, float (&f)[8]) {
    f[0] = (float)(w.x & 0xffu); f[1] = (float)((w.x >> 8) & 0xffu); f[2] = (float)((w.x >> 16) & 0xffu); f[3] = (float)(w.x >> 24);
    f[4] = (float)(w.y & 0xffu); f[5] = (float)((w.y >> 8) & 0xffu); f[6] = (float)((w.y >> 16) & 0xffu); f[7] = (float)(w.y >> 24); }
struct EpiP5 {
    static constexpr bool PERM = true, PERM16 = true;
    const unsigned char* S8a; const unsigned char* S8b;
    bf16_t* merged;
    unsigned char* part;
    __device__ __forceinline__ void operator()(f32x4 (&acc)[2][2][4][2], const Unit& u, int wr, int wc, int fr, int fq) const {
        const int n = u.aux & 3;
        const __amdgpu_buffer_rsrc_t rs = __builtin_amdgcn_make_buffer_rsrc((void*)(u.pm < HPAN ? S8a : S8b), 0, 0x7fffffff, 0x00020000);
        unsigned vo = (unsigned)(u.pm * 256 + wr * 64 + fr) * 4096u + (unsigned)(n * 1024 + u.pn * 256 + wc * 64 + 16 * fq); asm volatile("" : "+v"(vo));
        if (u.aux < 3) {
            u32x4 wa4[2][4], wb4[2][4];
#pragma unroll
            for (int ai = 0; ai < 2; ++ai)
#pragma unroll
                for (int m = 0; m < 4; ++m) { const int off = (ai * 128 + m * 16) * 4096;
                    wa4[ai][m] = __builtin_bit_cast(u32x4, __builtin_amdgcn_raw_buffer_load_b128(rs, (int)vo, off, 0));
                    wb4[ai][m] = __builtin_bit_cast(u32x4, __builtin_amdgcn_raw_buffer_load_b128(rs, (int)vo, off + 1024, 0)); }
#pragma unroll
            for (int ai = 0; ai < 2; ++ai)
#pragma unroll
                for (int bj = 0; bj < 2; ++bj)
#pragma unroll
                    for (int m = 0; m < 4; ++m) { float a[8], b[8]; dec8((u32x2){wa4[ai][m][2 * bj], wa4[ai][m][2 * bj + 1]}, a); dec8((u32x2){wb4[ai][m][2 * bj], wb4[ai][m][2 * bj + 1]}, b);
#pragma unroll
                        for (int e = 0; e < 4; ++e) { acc[ai][bj][m][0][e] *= a[e] * __builtin_amdgcn_rcpf(b[e]); acc[ai][bj][m][1][e] *= a[4 + e] * __builtin_amdgcn_rcpf(b[4 + e]); } }
        } else {
            const bool quarter = u.aux >= 4;
            unsigned lo = threadIdx.x * 16u; asm volatile("" : "+v"(lo));
            const int row0 = u.pm * 256 + wr * 64 + fr, col0 = u.pn * 256 + wc * 64 + 16 * fq;
            u32x4 w34[2][4];
#pragma unroll
            for (int ai = 0; ai < 2; ++ai)
#pragma unroll
                for (int m = 0; m < 4; ++m) w34[ai][m] = __builtin_bit_cast(u32x4, __builtin_amdgcn_raw_buffer_load_b128(rs, (int)vo, (ai * 128 + m * 16) * 4096, 0));
#pragma unroll
            for (int ai = 0; ai < 2; ++ai)
#pragma unroll
                for (int m = 0; m < 4; ++m)
#pragma unroll
                    for (int bj = 0; bj < 2; ++bj) { float a[8]; dec8((u32x2){w34[ai][m][2 * bj], w34[ai][m][2 * bj + 1]}, a);
                        const f32x4 v0 = acc[ai][bj][m][0] * (1.0f / 255.0f), v1 = acc[ai][bj][m][1] * (1.0f / 255.0f);
                        u32x4 w; w.x = pk2(v0[0] * a[0], v0[1] * a[1]); w.y = pk2(v0[2] * a[2], v0[3] * a[3]); w.z = pk2(v1[0] * a[4], v1[1] * a[5]); w.w = pk2(v1[2] * a[6], v1[3] * a[7]);
                        if (quarter) *(u32x4*)(part + ((ai * 2 + bj) * 4 + m) * 8192 + lo) = w;
                        else *(u32x4*)(merged + (size_t)(row0 + ai * 128 + m * 16) * DM + col0 + bj * 8) = w; }
        }
    }
};

struct EpiP6 {
    static constexpr bool PERM = true;
    const float* xin; const float* cin;
    const bf16_t* XB; bf16_t* XD; const float* MODL; float* ST;
    __device__ __forceinline__ void operator()(f32x4 (&acc)[2][2][4][2], const pg::Unit& u, int wr, int wc, int fr, int fq) const {
        const int row0 = u.pm * 256 + wr * 64 + fr, col0 = u.pn * 256 + wc * 32 + 8 * fq, ln = fq * 16 + fr;
        const float* gate = MODL + (size_t)mod_index(u.pm * 256) * 6144 + 2 * DM + col0;
        const f32x4 g00 = *(const f32x4*)gate, g01 = *(const f32x4*)(gate + 4), g10 = *(const f32x4*)(gate + 128), g11 = *(const f32x4*)(gate + 132);
#pragma unroll
        for (int ai = 0; ai < 2; ++ai) {
            float xv[4][2][8];
            if (xin) {
#pragma unroll
                for (int m = 0; m < 4; ++m) { const float* xr = xrow_c(xin, cin, row0 + ai * 128 + m * 16) + col0;
#pragma unroll
                    for (int bj = 0; bj < 2; ++bj) { const f32x4 a = *(const f32x4*)(xr + bj * 128), b = *(const f32x4*)(xr + bj * 128 + 4);
                        xv[m][bj][0] = a[0]; xv[m][bj][1] = a[1]; xv[m][bj][2] = a[2]; xv[m][bj][3] = a[3]; xv[m][bj][4] = b[0]; xv[m][bj][5] = b[1]; xv[m][bj][6] = b[2]; xv[m][bj][7] = b[3]; } }
            } else { u32x4 raw[4][2];
#pragma unroll
                for (int m = 0; m < 4; ++m)
#pragma unroll
                    for (int bj = 0; bj < 2; ++bj) raw[m][bj] = *(const u32x4*)(XB + (size_t)(row0 + ai * 128 + m * 16) * DM + col0 + bj * 128);
#pragma unroll
                for (int m = 0; m < 4; ++m)
#pragma unroll
                    for (int bj = 0; bj < 2; ++bj) unpack8(raw[m][bj], xv[m][bj]); }
#pragma unroll
            for (int m = 0; m < 4; ++m) { const int row = row0 + ai * 128 + m * 16; float ssq = 0.f;
#pragma unroll
                for (int bj = 0; bj < 2; ++bj) { const f32x4 ga = bj ? g10 : g00, gb = bj ? g11 : g01; float v[8];
#pragma unroll
                    for (int e = 0; e < 4; ++e) { v[e] = xv[m][bj][e] + ga[e] * acc[ai][bj][m][0][e]; v[4 + e] = xv[m][bj][4 + e] + gb[e] * acc[ai][bj][m][1][e]; ssq += v[e] * v[e] + v[4 + e] * v[4 + e]; }
                    u32x4 w; w.x = pk2(v[0], v[1]); w.y = pk2(v[2], v[3]); w.z = pk2(v[4], v[5]); w.w = pk2(v[6], v[7]);
                    *(u32x4*)(XD + (size_t)row * DM + col0 + bj * 128) = w; }
                ssq += shx(ssq, 16, ln); ssq += shx(ssq, 32, ln);
                if (fq == 0) ST[(size_t)row * 16 + u.pn * 4 + wc] = ssq; }
        }
    }
};
struct Norm2Raw { u32x4 a0, a1; f32x4 s0, s1, s2, s3; };
__device__ __forceinline__ void phase_norm2_router(const Ctx& C, int layer, const bf16_t* XN) {
    const float* ST = (const float*)(C.ws + WS_MIX + MIX_OUT);
    const float* g = C.in(I_N2G) + layer * DM; const float* MOD = (const float*)(C.ws + WS_MOD) + (size_t)layer * MODLD; bf16_t* H = (bf16_t*)(C.ws + WS_H);
    const float* rw = C.in(I_RW); const float* rb = C.in(I_RB);
    int* CLS = (int*)(C.ws + WS_MIX + MOE_CLS); f32x2* WTS = (f32x2*)(C.ws + WS_MIX + MOE_WTS); int* BLK = (int*)(C.ws + WS_MIX + MOE_BLK);
    constexpr int HLD = 1028;
    LAS float* HB = (LAS float*)C.lds;
    LAS float* PB = (LAS float*)(C.lds + 65792);
    LAS float* LG = (LAS float*)(C.lds + 65792 + 8192);
    LAS int* hist = (LAS int*)(C.lds + 65792 + 8192 + 9216);
    const int rows_per = NTOK / C.G;
    const int fe = C.lane & 15, fk = C.lane >> 4;
    float Bw[32];
#pragma unroll
    for (int sj = 0; sj < 32; ++sj) Bw[sj] = rw[(size_t)(C.wave * 128 + (sj >> 2) * 16 + fk * 4 + (sj & 3)) * 16 + fe];
    if (C.tid < 32) hist[C.tid] = 0;
    const int rbase = C.bid * rows_per + 2 * C.wave;
    const bool skip_all = false; (void)skip_all;
    Norm2Raw RA0, RA1, RB0, RB1;
#define P7_SKIP(r) (layer == DEPTH - 1 && ((r) % TPB) < CTX)
#define P7_LOAD(R, r) do { const bf16_t* xp_ = XN + (size_t)(r) * DM + 8 * C.lane; R.a0 = *(const u32x4*)xp_; R.a1 = *(const u32x4*)(xp_ + 512); const float* sp_ = ST + (size_t)(r) * 16;        \
        R.s0 = *(const f32x4*)sp_; R.s1 = *(const f32x4*)(sp_ + 4); R.s2 = *(const f32x4*)(sp_ + 8); R.s3 = *(const f32x4*)(sp_ + 12); } while (0)
    int mi_cur = -1; float Av[16], Sv[16];
#define P7_MOD(r) do { const int mi_ = mod_index(r); if (mi_ != mi_cur) { mi_cur = mi_; const float* m_ = MOD + (size_t)mi_ * 6144; \
        _Pragma("unroll") for (int q = 0; q < 4; ++q) { const int c_ = (q >> 1) * 512 + 8 * C.lane + (q & 1) * 4; const f32x4 gg = *(const f32x4*)(g + c_), sh = *(const f32x4*)(m_ + 3 * DM + c_), sc = *(const f32x4*)(m_ + 4 * DM + c_); \
            _Pragma("unroll") for (int j = 0; j < 4; ++j) { Av[q * 4 + j] = gg[j] * (1.0f + sc[j]); Sv[q * 4 + j] = sh[j]; } } } } while (0)
#define P7_ROW(R, r, slot) do { LAS float* hb = HB + (slot) * HLD + 8 * C.lane; float h[16]; \
        if (!P7_SKIP(r)) { P7_MOD(r); float v_[16]; { float t_[8]; unpack8(R.a0, t_); _Pragma("unroll") for (int j = 0; j < 8; ++j) v_[j] = t_[j]; unpack8(R.a1, t_); _Pragma("unroll") for (int j = 0; j < 8; ++j) v_[8 + j] = t_[j]; } \
            const f32x4 sq_ = (R.s0 + R.s1) + (R.s2 + R.s3); const float rstd_ = 1.0f / sqrtf(((sq_[0] + sq_[1]) + (sq_[2] + sq_[3])) * (1.0f / 1024.0f) + EPS); \
            _Pragma("unroll") for (int j = 0; j < 16; ++j) h[j] = v_[j] * rstd_ * Av[j] + Sv[j]; \
            store_h_wt(H + (size_t)(r) * DM, C.lane, h); } \
        else { float zf = 0.f; asm volatile("" : "+v"(zf)); _Pragma("unroll") for (int j = 0; j < 16; ++j) h[j] = zf; } \
        *(LAS f32x4*)hb = (f32x4){h[0], h[1], h[2], h[3]}; *(LAS f32x4*)(hb + 4) = (f32x4){h[4], h[5], h[6], h[7]}; *(LAS f32x4*)(hb + 512) = (f32x4){h[8], h[9], h[10], h[11]}; *(LAS f32x4*)(hb + 516) = (f32x4){h[12], h[13], h[14], h[15]}; } while (0)
    P7_LOAD(RA0, rbase); P7_LOAD(RA1, rbase + 1); P7_LOAD(RB0, rbase + 16); P7_LOAD(RB1, rbase + 17);
#define P7_ROUND(rd, RX0, RX1) do { const int r = rbase + (rd) * 16; \
        P7_ROW(RX0, r, 2 * C.wave); P7_ROW(RX1, r + 1, 2 * C.wave + 1); \
        if ((rd) + 2 < rows_per / 16) { P7_LOAD(RX0, r + 32); P7_LOAD(RX1, r + 33); }        \
        __syncthreads(); \
        { f32x4 acc0 = {0.f, 0.f, 0.f, 0.f}, acc1 = {0.f, 0.f, 0.f, 0.f}; const LAS float* ap = HB + fe * HLD + C.wave * 128 + fk * 4;        \
          _Pragma("unroll") for (int st = 0; st < 8; st += 2) { const f32x4 av = *(const LAS f32x4*)(ap + st * 16), aw = *(const LAS f32x4*)(ap + st * 16 + 16); \
              _Pragma("unroll") for (int j = 0; j < 4; ++j) { acc0 = __builtin_amdgcn_mfma_f32_16x16x4f32(av[j], Bw[st * 4 + j], acc0, 0, 0, 0); acc1 = __builtin_amdgcn_mfma_f32_16x16x4f32(aw[j], Bw[st * 4 + 4 + j], acc1, 0, 0, 0); } } \
          LAS float* pp = PB + C.wave * 256 + (fk * 4) * 16 + fe; \
          _Pragma("unroll") for (int j = 0; j < 4; ++j) pp[j * 16] = acc0[j] + acc1[j]; } \
        __syncthreads(); \
        if (C.tid < 256) { float sum = 0.f; \
            _Pragma("unroll") for (int w = 0; w < 8; ++w) sum += PB[w * 256 + C.tid]; \
            LG[(rd) * 256 + C.tid] = sum; } } while (0)
    for (int rd = 0; rd + 1 < rows_per / 16; rd += 2) { P7_ROUND(rd, RA0, RA1); P7_ROUND(rd + 1, RB0, RB1); }
    P7_ROUND(rows_per / 16 - 1, RA0, RA1);
#undef P7_ROUND
#undef P7_LOAD
#undef P7_ROW
#undef P7_MOD
    __syncthreads();
    if (C.tid < rows_per) {
        const int r = C.bid * rows_per + C.tid;
        if (P7_SKIP(r)) CLS[r] = -1;
        else {
        float lg[16];
#pragma unroll
        for (int q = 0; q < 4; ++q) { const f32x4 t = *(const LAS f32x4*)(LG + C.tid * 16 + q * 4); lg[q * 4] = t[0]; lg[q * 4 + 1] = t[1]; lg[q * 4 + 2] = t[2]; lg[q * 4 + 3] = t[3]; }
        float s[16], sb[16];
#pragma unroll
        for (int e = 0; e < 16; ++e) { s[e] = 1.0f / (1.0f + expf(-lg[e])); sb[e] = s[e] + rb[e]; }
        int gsel = 0; float gbest = -1e30f;
#pragma unroll
        for (int gi = 0; gi < 4; ++gi) { const float a0 = sb[gi * 4], a1 = sb[gi * 4 + 1], a2 = sb[gi * 4 + 2], a3 = sb[gi * 4 + 3];
            const float mx = fmaxf(fmaxf(a0, a1), fmaxf(a2, a3));
            const float hi01 = fmaxf(a0, a1), lo01 = fminf(a0, a1), hi23 = fmaxf(a2, a3), lo23 = fminf(a2, a3);
            const float second = fmaxf(fminf(hi01, hi23), fmaxf(lo01, lo23));
            const float sc = mx + second;
            if (sc > gbest) { gbest = sc; gsel = gi; } }
        float v[4], sv[4];
#pragma unroll
        for (int j = 0; j < 4; ++j) { v[j] = gsel == 0 ? sb[j] : gsel == 1 ? sb[4 + j] : gsel == 2 ? sb[8 + j] : sb[12 + j]; sv[j] = gsel == 0 ? s[j] : gsel == 1 ? s[4 + j] : gsel == 2 ? s[8 + j] : s[12 + j]; }
        int i1 = 0; float m1 = v[0];
#pragma unroll
        for (int j = 1; j < 4; ++j) if (v[j] > m1) { i1 = j; m1 = v[j]; }
        int i2 = -1; float m2 = -1e30f;
#pragma unroll
        for (int j = 0; j < 4; ++j) if (j != i1 && v[j] > m2) { i2 = j; m2 = v[j]; }
        const int lo = i1 < i2 ? i1 : i2, hi = i1 < i2 ? i2 : i1;
        const float slo = lo == 0 ? sv[0] : (lo == 1 ? sv[1] : sv[2]), shi = hi == 1 ? sv[1] : (hi == 2 ? sv[2] : sv[3]), inv = 1.0f / (slo + shi);
        const int pair = lo == 0 ? hi - 1 : (lo == 1 ? hi + 1 : 5);
        const int cls = gsel * 6 + pair;
        CLS[r] = cls; WTS[r] = (f32x2){slo * inv, shi * inv}; __hip_atomic_fetch_add(hist + cls, 1, __ATOMIC_RELAXED, __HIP_MEMORY_SCOPE_WORKGROUP);
        }
    }
#undef P7_SKIP
    __syncthreads();
    if (C.tid < 32) BLK[C.bid * 32 + C.tid] = C.tid < 24 ? hist[C.tid] : 0;
}
__device__ __forceinline__ void class_experts(int cls, int& ea, int& eb) { const int g = cls / 6, p = cls - g * 6; const int lo = p < 3 ? 0 : (p < 5 ? 1 : 2); const int hi = p < 3 ? p + 1 : (p < 5 ? p - 1 : 3); ea = g * 4 + lo; eb = g * 4 + hi; }
__device__ __forceinline__ void phase_sort(const Ctx& C) {
    const int* CLS = (const int*)(C.ws + WS_MIX + MOE_CLS); const f32x2* WTS = (const f32x2*)(C.ws + WS_MIX + MOE_WTS); const int* BLK = (const int*)(C.ws + WS_MIX + MOE_BLK);
    int* TILE = (int*)(C.ws + WS_MIX + MOE_TILE); int* SIDX = (int*)(C.ws + WS_MIX + MOE_SIDX); f32x2* SW = (f32x2*)(C.ws + WS_MIX + MOE_SW);
    LAS int* tot = (LAS int*)C.lds; LAS int* pre = tot + 32; LAS int* base = tot + 64; LAS int* lcls = tot + 128;
    const int rows_per = NTOK / C.G;
    __syncthreads();
    for (int c = C.wave; c < 24; c += 8) { int t = 0, p = 0;
        for (int b = C.lane; b < C.G; b += 64) { const int v = BLK[b * 32 + c]; t += v; p += b < C.bid ? v : 0; }
        for (int o = 32; o >= 1; o >>= 1) { t += shxi(t, o, C.lane); p += shxi(p, o, C.lane); }
        if (C.lane == 0) { tot[c] = t; pre[c] = p; } }
    __syncthreads();
    if (C.tid == 0) { int acc = 0; for (int c = 0; c < 24; ++c) { base[c] = acc * 256; acc += (tot[c] + 255) >> 8; } base[24] = acc; }
    for (int i = C.tid; i < rows_per; i += 512) lcls[i] = CLS[C.bid * rows_per + i];
    __syncthreads();
    for (int i = C.tid; i < rows_per; i += 512) { const int c = lcls[i]; if (c < 0) continue; int rank = 0; for (int j = 0; j < i; ++j) rank += lcls[j] == c ? 1 : 0;
        const int pos = base[c] + pre[c] + rank, r = C.bid * rows_per + i; SIDX[pos] = r; SW[pos] = WTS[r]; }
    if (C.bid == 0) {
        if (C.tid == 0) TILE[0] = base[24];
        for (int c = C.wave; c < 24; c += 8) { const int nt = (tot[c] + 255) >> 8, t0 = base[c] >> 8;
            for (int j = C.lane; j < nt; j += 64) { TILE[8 + (t0 + j) * 2] = c; TILE[8 + (t0 + j) * 2 + 1] = min(256, tot[c] - j * 256); }
            for (int j = tot[c] + C.lane; j < nt * 256; j += 64) { float zf = 0.f; asm volatile("" : "+v"(zf)); SIDX[base[c] + j] = 0; SW[base[c] + j] = (f32x2){zf, zf}; } }
    }
}
struct SchedMoe1 {
    static constexpr bool GATHER = true, FP8 = false;
    const char* H; const char* W13; const int* TILE; const int* SIDX; int ntiles, G, c;
    __device__ __forceinline__ bool next(int i, Unit& u) const { const long L = (long)i * G + c; if (L >= (long)ntiles * 4) return false; u.aux = (int)(L >> 2); u.pn = (int)(L & 3); u.pm = __builtin_amdgcn_readfirstlane(ld_agent(TILE + 8 + u.aux * 2)); return true; }
    __device__ __forceinline__ void setup(const Unit& u, const char*& a, const char*& b0, const char*& b1, unsigned& lda, unsigned& ldb, int& nt, int& nt0) const {
        int ea, eb; class_experts(u.pm, ea, eb); const int e = u.pn < 2 ? ea : eb;
        a = H; b0 = W13 + ((size_t)e * 512 + (u.pn & 1) * 256) * 2048; b1 = b0; nt = 16; nt0 = 16; lda = 2048u; ldb = 2048u; }
    __device__ __forceinline__ unsigned rowoff(const Unit& u, int r) const { return (unsigned)SIDX[u.aux * 256 + r] * 2048u; }
    __device__ __forceinline__ bool keep_acc(const Unit&) const { return false; }
};
struct EpiMoe1 {
    static constexpr bool PERM = true, PERM16 = true;
    bf16_t* ACT; const int* TILE; const f32x2* SW;
    __device__ __forceinline__ void operator()(f32x4 (&acc)[2][2][4][2], const Unit& u, int wr, int wc, int fr, int fq) const {
        const int tile = u.aux, nrows = __builtin_amdgcn_readfirstlane(ld_agent(TILE + 8 + tile * 2 + 1)), sel = u.pn >> 1;
        const int ac0 = sel * 256 + (u.pn & 1) * 128 + wc * 32 + 8 * fq;
#pragma unroll
        for (int ai = 0; ai < 2; ++ai)
#pragma unroll
            for (int m = 0; m < 4; ++m) { const int r = ai * 128 + wr * 64 + m * 16 + fr; const size_t pos = (size_t)tile * 256 + r;
                const f32x2 ww = SW[pos]; const float w = r < nrows ? (sel ? ww.y : ww.x) : 0.f; u32x4 o;
#pragma unroll
                for (int bj = 0; bj < 2; ++bj) { const f32x4 v0 = acc[ai][bj][m][0], v1 = acc[ai][bj][m][1];
                    const float o0 = v0[0] * fast_sigmoid(v0[0]) * v0[1] * w, o1 = v0[2] * fast_sigmoid(v0[2]) * v0[3] * w, o2 = v1[0] * fast_sigmoid(v1[0]) * v1[1] * w, o3 = v1[2] * fast_sigmoid(v1[2]) * v1[3] * w;
                    if (bj == 0) { o.x = pk2(o0, o1); o.y = pk2(o2, o3); } else { o.z = pk2(o0, o1); o.w = pk2(o2, o3); } }
                *(u32x4*)(ACT + pos * 512 + ac0) = o; }
    }
};
struct SchedMoe2 {
    static constexpr bool GATHER = false, FP8 = false;
    const char* ACT; const char* W2; const int* TILE; int ntiles, G, c;
    __device__ __forceinline__ bool next(int i, Unit& u) const { const long L = (long)i * G + c; if (L >= (long)ntiles * 4) return false; u.aux = (int)(L >> 2); u.pn = (int)(L & 3); u.pm = __builtin_amdgcn_readfirstlane(ld_agent(TILE + 8 + u.aux * 2)); return true; }
    __device__ __forceinline__ void setup(const Unit& u, const char*& a, const char*& b0, const char*& b1, unsigned& lda, unsigned& ldb, int& nt, int& nt0) const {
        int ea, eb; class_experts(u.pm, ea, eb);
        a = ACT + (size_t)u.aux * 256 * 1024; b0 = W2 + ((size_t)ea * 1024 + u.pn * 256) * 512; b1 = W2 + ((size_t)eb * 1024 + u.pn * 256) * 512; nt = 8; nt0 = 4; lda = 1024u; ldb = 512u; }
    __device__ __forceinline__ unsigned rowoff(const Unit&, int) const { return 0u; }
    __device__ __forceinline__ bool keep_acc(const Unit&) const { return false; }
};
struct EpiMoe2 {
    static constexpr bool PERM = true;
    bf16_t* Y; const int* TILE; const int* SIDX; bf16_t* dummy;
    __device__ __forceinline__ void operator()(f32x4 (&acc)[2][2][4][2], const Unit& u, int wr, int wc, int fr, int fq) const {
        const int tile = u.aux, nrows = __builtin_amdgcn_readfirstlane(ld_agent(TILE + 8 + tile * 2 + 1)); const int col0 = u.pn * 256 + wc * 32 + 8 * fq;
#pragma unroll
        for (int ai = 0; ai < 2; ++ai)
#pragma unroll
            for (int m = 0; m < 4; ++m) { const int r = ai * 128 + wr * 64 + m * 16 + fr;
                const int tok = SIDX[tile * 256 + r]; bf16_t* yr = (r < nrows ? Y + (size_t)tok * DM : dummy) + col0;
#pragma unroll
                for (int bj = 0; bj < 2; ++bj) { const f32x4 v0 = acc[ai][bj][m][0], v1 = acc[ai][bj][m][1];
                    u32x4 w; w.x = pk2(v0[0], v0[1]); w.y = pk2(v0[2], v0[3]); w.z = pk2(v1[0], v1[1]); w.w = pk2(v1[2], v1[3]);
                    *(u32x4*)(yr + bj * 128) = w; } }
    }
};

constexpr int NPH_LAYER = 16, NPHASES = 1 + DEPTH * NPH_LAYER + 1;
#define EN(k) (((MASK) >> (k)) & 1)
#ifndef MK_DUP
#define MK_DUP 0
#endif
#define REP(k) for (int rep_ = 0; rep_ < (((MK_DUP) >> (k)) & 1) + 1; ++rep_)
template <int MASK>
__global__ void __launch_bounds__(512, 2) fwd(Args args) {
    extern __shared__ __attribute__((aligned(16))) unsigned char lds_raw[];
    Ctx C0; C0.kin = (const float* const __attribute__((address_space(4)))*)__builtin_amdgcn_kernarg_segment_ptr(); C0.ws = args.ws; C0.lds = (LAS unsigned char*)lds_raw; C0.tid = threadIdx.x; C0.lane = C0.tid & 63; C0.wave = __builtin_amdgcn_readfirstlane(C0.tid >> 6); C0.G = gridDim.x; C0.bid = blockIdx.x;
    volatile LAS unsigned* misc = (volatile LAS unsigned*)(C0.lds + LDS_MISC);
    if (C0.tid < 4) misc[C0.tid] = 0u;
    __syncthreads();
    const int lo = args.ph_lo, hi = args.ph_hi;
    XcdBarrier bar; bar.bar = (unsigned*)(C0.ws + WS_BAR); bar.x = 0; bar.st = misc;
    if (hi - lo > 1) bar = xcd_barrier_post((unsigned*)(C0.ws + WS_BAR), misc);
#define IN(k) (lo <= (k) && (k) < hi)
#ifndef MK_BAR2
#define MK_BAR2 0
#endif
#define SEAM(k) do { if (IN(k) && IN((k) + 1)) { xcd_barrier(bar); if (MK_BAR2) xcd_barrier(bar); } } while (0)
#define PHASE_CTX(P) Ctx P = C0; { int t_ = C0.tid; asm volatile("" : "+v"(t_)); P.tid = t_; P.lane = t_ & 63; P.wave = __builtin_amdgcn_readfirstlane(t_ >> 6); \
        unsigned long long w_ = (unsigned long long)C0.ws; asm volatile("" : "+s"(w_)); P.ws = (unsigned char*)(__attribute__((address_space(1))) unsigned char*)w_;        \
        unsigned long long k_ = (unsigned long long)C0.kin; asm volatile("" : "+s"(k_)); P.kin = (const float* const __attribute__((address_space(4)))*)k_; } \
        unsigned char* ws = P.ws; unsigned char* W = ws + WS_W; unsigned char* mix = ws + WS_MIX; float* xl = (float*)P.in(N_INPUTS); bf16_t* XB = (bf16_t*)xl; bf16_t* XB2 = (bf16_t*)(ws + WS_BR); (void)W; (void)mix; (void)xl; (void)XB; (void)XB2

    if (EN(15) && IN(0)) { { PHASE_CTX(C); phase_prologue(C); } { PHASE_CTX(C); __syncthreads(); phase_cvt(C, 0); } }
    SEAM(0);
    for (int layer = 0; layer < DEPTH; ++layer) {
        const int pb = 1 + layer * NPH_LAYER;
        if (EN(0) && IN(pb)) { PHASE_CTX(C); if (layer > 0) phase_cvt(C, layer); phase_norm1(C, layer, XB); }
        SEAM(pb);
        for (int st = 0; st < 5; ++st) {
            if (EN(4) && (st == 2 || st == 4)) { const int half = (st - 2) >> 1; { PHASE_CTX(C); phase_attn(C, layer, half, layer < DEPTH - 1); } __syncthreads(); }
            if (EN(1) && (st == 0 || st == 2)) { const int half = st >> 1;
                PHASE_CTX(C);
                pg::SchedGrid S; S.init(ws + WS_H + (size_t)half * HROWS * 2048, 2048, W + W_IN, 2048, 1024, HPAN, 14);
                pg::EpiP2 E{(bf16_t*)(mix + MIX_P), (float*)(ws + WS_SS), (float*)(mix + MIX_Q) + (size_t)half * HROWS * 16};
                pg::gemm_phase(C.lds, S, E);
            }
            if (EN(2) && (st == 1 || st == 3)) { const int half = (st - 1) >> 1;
                { PHASE_CTX(C); SchedQKV S{(const char*)(mix + MIX_P), (const char*)(W + W_UQ), (const char*)(W + W_UKV), C.G, C.bid}; EpiQKV E{(bf16_t*)(mix + MIX_QRAW), (bf16_t*)(mix + MIX_KVRAW), (bf16_t*)(mix + MIX_K), (const bf16_t*)(mix + MIX_P), (const float*)(mix + MIX_Q) + (size_t)half * HROWS * 16, C.in(I_KNG) + layer * 96, (const float*)(ws + WS_ROPE)}; pg::gemm_phase(C.lds, S, E); }
                { PHASE_CTX(C); phase_conv(C, layer, half); }
                { PHASE_CTX(C); phase_pool(C, half); }
                { PHASE_CTX(C); phase_sgu(C, layer, half); }
            }
            if (EN(6) && st == 4) {
                PHASE_CTX(C);
                pg::SchedGrid8 S; if (layer == DEPTH - 1) S.init(ws + WS_H8, 1024, W + W_G, 1024, 512, 128, 16, 1); else S.init(ws + WS_H8, 1024, W + W_G, 1024, 512, NPAN, 16);
                EpiGate8 E{mix + MIX_S8, ws + WS_BR};
                pg::gemm_phase(C.lds, S, E);
            }
            SEAM(pb);
        }
        if (EN(9) && IN(pb + 10)) REP(9) {
            PHASE_CTX(C);
            SchedP5 S{(const char*)(ws + WS_BR), (const char*)(W + W_B), C.G, C.bid, layer == DEPTH - 1};
            unsigned char* PART = mix + MOE_CLS;
            EpiP5 E{mix + MIX_S8, ws + WS_BR, (bf16_t*)(mix + MIX_MERGED), PART + (size_t)C.bid * 131072};
            pg::gemm_phase(C.lds, S, E);
            if (layer < DEPTH - 1) {
            asm volatile("s_waitcnt vmcnt(0)" ::: "memory"); __syncthreads();
            volatile LAS int* lastf = (volatile LAS int*)(C.lds + LDS_MISC + 64);
            if (C.tid == 0) {
                __builtin_amdgcn_fence(__ATOMIC_RELEASE, "agent"); asm volatile("s_waitcnt vmcnt(0)" ::: "memory");
                const unsigned old = __hip_atomic_fetch_add((unsigned*)(ws + WS_BAR + 16384) + 64 * (C.bid >> 2), 1u, __ATOMIC_RELAXED, __HIP_MEMORY_SCOPE_AGENT);
                const int last = (old & 3u) == 3u; *lastf = last;
                if (last) { __builtin_amdgcn_fence(__ATOMIC_ACQUIRE, "agent"); asm volatile("s_waitcnt vmcnt(0)" ::: "memory"); }
            }
            __syncthreads();
            if (*lastf) {
                int pm, pn; pg::grid_tile(512 + (C.bid >> 2), NPAN, 4, pm, pn);
                const int wid = C.tid >> 6, wr = wid >> 2, wc = wid & 3, fr = C.lane & 15, fq = C.lane >> 4;
                const unsigned char* p0 = PART + (size_t)(C.bid & ~3) * 131072 + C.tid * 16; bf16_t* MG = (bf16_t*)(mix + MIX_MERGED);
#pragma unroll 4
                for (int j = 0; j < 16; ++j) { const int ai = j >> 3, bj = (j >> 2) & 1, m = j & 3; float sum[8];
#pragma unroll
                    for (int e = 0; e < 8; ++e) sum[e] = 0.f;
#pragma unroll
                    for (int q = 0; q < 4; ++q) { float f[8]; unpack8(*(const u32x4*)(p0 + (size_t)q * 131072 + j * 8192), f);
#pragma unroll
                        for (int e = 0; e < 8; ++e) sum[e] += f[e]; }
                    u32x4 w; w.x = pk2(sum[0], sum[1]); w.y = pk2(sum[2], sum[3]); w.z = pk2(sum[4], sum[5]); w.w = pk2(sum[6], sum[7]);
                    *(u32x4*)(MG + (size_t)(pm * 256 + ai * 128 + wr * 64 + m * 16 + fr) * DM + pn * 256 + wc * 64 + 16 * fq + 8 * bj) = w; }
            }
            }
        }
        SEAM(pb + 10);
        if (EN(10) && IN(pb + 11)) REP(10) {
            PHASE_CTX(C);
            pg::SchedGrid S; if (layer == DEPTH - 1) S.init(mix + MIX_MERGED, 2048, W + W_O, 2048, 1024, 128, 4, 1); else S.init(mix + MIX_MERGED, 2048, W + W_O, 2048, 1024, NPAN, 4);
            EpiP6 E{layer == 0 ? C.in(I_X) : nullptr, C.in(I_CTX), XB, layer == DEPTH - 1 ? XB2 : XB, (const float*)(ws + WS_MOD) + (size_t)layer * MODLD, (float*)(mix + MIX_OUT)};
            pg::gemm_phase(C.lds, S, E);
        }
        SEAM(pb + 11);
        if (EN(11) && IN(pb + 12)) { PHASE_CTX(C); phase_norm2_router(C, layer, layer == DEPTH - 1 ? XB2 : XB); }
        SEAM(pb + 12);
        if (EN(12) && IN(pb + 13)) REP(12) { PHASE_CTX(C); phase_sort(C); }
        SEAM(pb + 13);
        if (EN(13) && IN(pb + 14)) REP(13) {
            PHASE_CTX(C);
            const int* TILE = (const int*)(mix + MOE_TILE);
            const int ntiles = min(__builtin_amdgcn_readfirstlane(ld_agent(TILE)), MAXT);
            const int vcu = (C.G % 8 == 0) ? (C.bid % 8) * (C.G / 8) + C.bid / 8 : C.bid;
            SchedMoe1 S{(const char*)(ws + WS_H), (const char*)(W + W_13), TILE, (const int*)(mix + MOE_SIDX), ntiles, C.G, vcu};
            EpiMoe1 E{(bf16_t*)(mix + MOE_ACT), TILE, (const f32x2*)(mix + MOE_SW)};
            pg::gemm_phase(C.lds, S, E);
        }
        SEAM(pb + 14);
        if (EN(14) && IN(pb + 15)) REP(14) {
            PHASE_CTX(C);
            const int* TILE = (const int*)(mix + MOE_TILE);
            const int ntiles = min(__builtin_amdgcn_readfirstlane(ld_agent(TILE)), MAXT);
            const int vcu = (C.G % 8 == 0) ? (C.bid % 8) * (C.G / 8) + C.bid / 8 : C.bid;
            SchedMoe2 S{(const char*)(mix + MOE_ACT), (const char*)(W + W_2), TILE, ntiles, C.G, vcu};
            EpiMoe2 E{(bf16_t*)(mix + MIX_OUT), TILE, (const int*)(mix + MOE_SIDX), (bf16_t*)(ws + WS_BAR + 32768)};
            pg::gemm_phase(C.lds, S, E);
        }
        SEAM(pb + 15);
    }
    if (EN(5) && IN(NPHASES - 1)) { PHASE_CTX(C); phase_final(C, xl, XB2); }
#undef IN
#undef SEAM
#undef PHASE_CTX
}

#ifndef MK_ONE_LAUNCH
#define MK_ONE_LAUNCH 1
#endif
typedef void (*kern_t)(Args);
extern "C" void kernel_launch(void* const* d_in, const int* in_sizes, int n_in, void* d_out, int out_size, void* d_ws, size_t ws_size, hipStream_t stream) {
    static int grid = 0;
    static const kern_t kerns[1] = { fwd<0xFFFF> };
    constexpr int NK = 1;
    if (grid == 0) {
        if (n_in != N_INPUTS || out_size != NB * LAT * DM || ws_size < WS_END) { fprintf(stderr, "kernel_launch: unexpected shapes or workspace (n_in %d out %d ws %zu, need %zu)\n", n_in, out_size, ws_size, (size_t)WS_END); grid = -1; return; }
        int dev = 0, cus = 0;
        if (hipGetDevice(&dev) != hipSuccess || hipDeviceGetAttribute(&cus, hipDeviceAttributeMultiprocessorCount, dev) != hipSuccess) { grid = -1; return; }
        for (int i = 0; i < NK; ++i) if (kerns[i]) {
            if (hipFuncSetAttribute((const void*)kerns[i], hipFuncAttributeMaxDynamicSharedMemorySize, LDS_BYTES) != hipSuccess) { fprintf(stderr, "kernel_launch: hipFuncSetAttribute failed\n"); grid = -1; return; }
            int per_cu = 0;
            if (hipOccupancyMaxActiveBlocksPerMultiprocessor(&per_cu, (const void*)kerns[i], 512, LDS_BYTES) != hipSuccess || per_cu < 1) fprintf(stderr, "kernel_launch: occupancy query says %d for kernel %d\n", per_cu, i);
        }
        (void)hipGetLastError();
        grid = cus;
        if (grid != 256) { fprintf(stderr, "kernel_launch: built for 256 CUs (one workgroup each), device has %d\n", grid); grid = -1; return; }
        if (NTOK % grid != 0) { fprintf(stderr, "kernel_launch: grid %d does not divide the token count\n", grid); grid = -1; return; }
    }
    if (grid < 0) return;
    (void)hipMemsetAsync((char*)d_ws + WS_BAR, 0, 65536, stream);
    Args a{};
    for (int i = 0; i < N_INPUTS; ++i) a.in[i] = (const float*)d_in[i];
    a.out = (float*)d_out; a.ws = (unsigned char*)d_ws;
    a.ph_lo = 0; a.ph_hi = NPHASES;
    hipLaunchKernelGGL(kerns[0], dim3(grid), dim3(512), LDS_BYTES, stream, a);
    const hipError_t le = hipPeekAtLastError();
    if (le != hipSuccess) fprintf(stderr, "kernel_launch: launch failed: %s\n", hipGetErrorName(le));
}
```
